# Optimizing an MI355X kernel written in HIP

```python
import math
import jax
import jax.numpy as jnp
from jax import lax
import numpy as np

D_MODEL = 1024
BATCH = 8
SEQ = 2048
DEPTH = 4

GRID_W = 64
CTX_LEN = 256
HEAD_DIM = 64
ROPE_THETA = 10000.0
RMS_EPS = 1e-6
LN_EPS = 1e-5
NEG_INF = -1e30
Q_BLOCK = 128

MLA_HEADS = 4
MLA_Q_LORA = 256
MLA_KV_LORA = 128
MLA_NOPE = 64
MLA_ROPE = 32
MLA_V = 64

GQA_Q_HEADS = 4
GQA_KV_HEADS = 2
WINDOW = 128
W_BLOCK = 128

S5_CHANNELS = 256
S5_GROUP = 16
S5_GROUPS = S5_CHANNELS // S5_GROUP
S5_STATE = 64
S5_DT_MIN = 1e-3
S5_DT_MAX = 1e-1

GMLP_WIDTH = 256
GMLP_CHUNK = 128
GMLP_GROUPS = 4
GMLP_GROUP_DIM = GMLP_WIDTH // GMLP_GROUPS

N_BRANCH = 4
BRANCH_WIDTH = 256
D_FF = 2816
MACARON_WEIGHT = 0.5
N_MOD = 9
MOD_CTX_LAST = 5

SEG_WIDTHS = (MLA_KV_LORA, MLA_ROPE, GQA_KV_HEADS * HEAD_DIM, GQA_KV_HEADS * HEAD_DIM, S5_CHANNELS, MLA_Q_LORA, GQA_Q_HEADS * HEAD_DIM, 2 * GMLP_WIDTH, N_BRANCH * D_MODEL)
N_CTX_SEGS = 5
IN_COLS = MLA_KV_LORA + MLA_ROPE + 2 * GQA_KV_HEADS * HEAD_DIM + S5_CHANNELS + MLA_Q_LORA + GQA_Q_HEADS * HEAD_DIM + 2 * GMLP_WIDTH + N_BRANCH * D_MODEL

kernel_name = 'hybrid_prefix_dit_trunk'

F32 = jnp.float32


def split_cols(p, widths):
    parts, start = [], 0
    for w in widths:
        parts.append(p[..., start:start + w])
        start += w
    return parts


def rms_norm(x, gain):
    xf = x.astype(F32)
    y = xf * lax.rsqrt(jnp.mean(xf * xf, axis=-1, keepdims=True) + RMS_EPS)
    return (y * gain.astype(F32)).astype(x.dtype)


def layer_norm(x, gain):
    xf = x.astype(F32)
    xc = xf - jnp.mean(xf, axis=-1, keepdims=True)
    y = xc * lax.rsqrt(jnp.mean(xc * xc, axis=-1, keepdims=True) + LN_EPS)
    return (y * gain.astype(F32)).astype(x.dtype)


def axial_rope_tables(rows, rot_dim):
    axis_dim = rot_dim // 2
    inv_freq = ROPE_THETA ** (-jnp.arange(0, axis_dim, 2, dtype=F32) / axis_dim)
    row = jnp.repeat(jnp.arange(rows, dtype=F32), GRID_W)
    col = jnp.tile(jnp.arange(GRID_W, dtype=F32), rows)
    ang_r = row[:, None] * inv_freq[None, :]
    ang_c = col[:, None] * inv_freq[None, :]
    return (jnp.cos(ang_r), jnp.sin(ang_r), jnp.cos(ang_c), jnp.sin(ang_c))


def _rotate_half(x, cos, sin):
    x1, x2 = jnp.split(x, 2, axis=-1)
    cos = cos[None, :, None, :]
    sin = sin[None, :, None, :]
    return jnp.concatenate([x1 * cos - x2 * sin, x2 * cos + x1 * sin], axis=-1)


def axial_rope(x, tables):
    cos_r, sin_r, cos_c, sin_c = tables
    x_row, x_col = jnp.split(x.astype(F32), 2, axis=-1)
    out = jnp.concatenate([_rotate_half(x_row, cos_r, sin_r), _rotate_half(x_col, cos_c, sin_c)], axis=-1)
    return out.astype(x.dtype)


def blocked_attention(q, k, v, scale):
    b, lq, h, d = q.shape
    nb = lq // Q_BLOCK
    qb = q.reshape(b, nb, Q_BLOCK, h, d).transpose(1, 0, 2, 3, 4)

    def one_block(q_blk):
        s = jnp.einsum('bqhd,bkhd->bhqk', q_blk, k).astype(F32) * scale
        p = jax.nn.softmax(s, axis=-1).astype(v.dtype)
        return jnp.einsum('bhqk,bkhd->bqhd', p, v)

    o = lax.map(one_block, qb)
    return o.transpose(1, 0, 2, 3, 4).reshape(b, lq, h, v.shape[-1])


def mla_queries(q_lora, norm_g, w_uq, rope):
    b, n, _ = q_lora.shape
    q = (rms_norm(q_lora, norm_g) @ w_uq).reshape(b, n, MLA_HEADS, MLA_NOPE + MLA_ROPE)
    q_nope, q_pe = q[..., :MLA_NOPE], q[..., MLA_NOPE:]
    if rope is not None:
        q_pe = axial_rope(q_pe, rope)
    return jnp.concatenate([q_nope, q_pe], axis=-1)


def mla_keys_values(kv_lora, k_pe, norm_g, w_ukv, rope):
    b, n, _ = kv_lora.shape
    kv = (rms_norm(kv_lora, norm_g) @ w_ukv).reshape(b, n, MLA_HEADS, MLA_NOPE + MLA_V)
    k_nope, v = kv[..., :MLA_NOPE], kv[..., MLA_NOPE:]
    k_pe = k_pe[:, :, None, :]
    if rope is not None:
        k_pe = axial_rope(k_pe, rope)
    k = jnp.concatenate([k_nope, jnp.broadcast_to(k_pe, (b, n, MLA_HEADS, MLA_ROPE))], axis=-1)
    return k, v


def window_gqa_latent(q, k, v, kc, vc, sink):
    b, n, hq, d = q.shape
    hkv = k.shape[2]
    g = hq // hkv
    nb = n // W_BLOCK
    nc = kc.shape[1]
    scale = d ** -0.5

    def band(t):
        tp = jnp.pad(t, ((0, 0), (W_BLOCK, W_BLOCK), (0, 0), (0, 0)))
        tp = tp.reshape(b, nb + 2, W_BLOCK, hkv, d)
        return jnp.concatenate([tp[:, :-2], tp[:, 1:-1], tp[:, 2:]], axis=2)

    kb, vb = band(k), band(v)
    qb = q.reshape(b, nb, W_BLOCK, hkv, g, d)
    s_band = jnp.einsum('bnqkgd,bnjkd->bnkgqj', qb, kb).astype(F32) * scale
    qpos = jnp.arange(nb)[:, None] * W_BLOCK + jnp.arange(W_BLOCK)[None, :]
    kpos = jnp.arange(nb)[:, None] * W_BLOCK - W_BLOCK + jnp.arange(3 * W_BLOCK)[None, :]
    valid = ((jnp.abs(qpos[:, :, None] - kpos[:, None, :]) <= WINDOW)
             & (kpos[:, None, :] >= 0) & (kpos[:, None, :] < n))
    s_band = jnp.where(valid[None, :, None, None], s_band, NEG_INF)
    s_ctx = jnp.einsum('bnqkgd,bjkd->bnkgqj', qb, kc).astype(F32) * scale
    sink_l = jnp.broadcast_to(sink.astype(F32).reshape(1, 1, hkv, g, 1, 1), s_band.shape[:-1] + (1,))
    probs = jax.nn.softmax(jnp.concatenate([s_band, s_ctx, sink_l], axis=-1), axis=-1).astype(v.dtype)
    nbk = 3 * W_BLOCK
    o = (jnp.einsum('bnkgqj,bnjkd->bnqkgd', probs[..., :nbk], vb)
         + jnp.einsum('bnkgqj,bjkd->bnqkgd', probs[..., nbk:nbk + nc], vc))
    return o.reshape(b, n, hq, d)


def sink_gqa_context(q, k, v, sink):
    b, n, hq, d = q.shape
    hkv = k.shape[2]
    g = hq // hkv
    qg = q.reshape(b, n, hkv, g, d)
    s = jnp.einsum('bqkgd,bjkd->bkgqj', qg, k).astype(F32) * d ** -0.5
    sink_l = jnp.broadcast_to(sink.astype(F32).reshape(1, hkv, g, 1, 1), s.shape[:-1] + (1,))
    p = jax.nn.softmax(jnp.concatenate([s, sink_l], axis=-1), axis=-1)[..., :-1].astype(v.dtype)
    return jnp.einsum('bkgqj,bjkd->bqkgd', p, v).reshape(b, n, hq, d)


def s5_discretize(lam_re, lam_im, log_dt, b_re, b_im):
    lam_re = jnp.minimum(lam_re.astype(F32), -1e-4)
    lam_im = lam_im.astype(F32)
    dt = jnp.exp(log_dt.astype(F32))[:, None]
    mag = jnp.exp(lam_re * dt)
    a_re = mag * jnp.cos(lam_im * dt)
    a_im = mag * jnp.sin(lam_im * dt)
    nr, ni = a_re - 1.0, a_im
    den = lam_re * lam_re + lam_im * lam_im
    coef_re = (nr * lam_re + ni * lam_im) / den
    coef_im = (ni * lam_re - nr * lam_im) / den
    b_re, b_im = b_re.astype(F32), b_im.astype(F32)
    bb_re = coef_re[..., None] * b_re - coef_im[..., None] * b_im
    bb_im = coef_re[..., None] * b_im + coef_im[..., None] * b_re
    return a_re, a_im, bb_re, bb_im


def _complex_affine_combine(e1, e2):
    a1r, a1i, b1r, b1i = e1
    a2r, a2i, b2r, b2i = e2
    return (a2r * a1r - a2i * a1i, a2r * a1i + a2i * a1r,
            a2r * b1r - a2i * b1i + b2r, a2r * b1i + a2i * b1r + b2i)


def s5_states(u, disc, s0, reverse):
    a_re, a_im, bb_re, bb_im = disc
    bu_re = jnp.einsum('blgh,gph->blgp', u, bb_re)
    bu_im = jnp.einsum('blgh,gph->blgp', u, bb_im)
    if s0 is not None:
        s0_re, s0_im = s0
        first = -1 if reverse else 0
        bu_re = bu_re.at[:, first].add(a_re * s0_re - a_im * s0_im)
        bu_im = bu_im.at[:, first].add(a_re * s0_im + a_im * s0_re)
    elems = (jnp.broadcast_to(a_re, bu_re.shape), jnp.broadcast_to(a_im, bu_re.shape), bu_re, bu_im)
    _, _, s_re, s_im = lax.associative_scan(_complex_affine_combine, elems, reverse=reverse, axis=1)
    return s_re, s_im


def s5_readout(states, c_re, c_im):
    s_re, s_im = states
    return jnp.einsum('blgp,ghp->blgh', s_re, c_re) - jnp.einsum('blgp,ghp->blgh', s_im, c_im)


def s5_output(u, fwd, bwd, c_re, c_im, d_skip, w_glu, b_glu, out_dtype):
    c_re, c_im = c_re.astype(F32), c_im.astype(F32)
    y = (s5_readout(fwd, c_re[0], c_im[0]) + s5_readout(bwd, c_re[1], c_im[1])
         + d_skip.astype(F32).reshape(S5_GROUPS, S5_GROUP) * u)
    y = jax.nn.gelu(y.reshape(u.shape[0], u.shape[1], S5_CHANNELS))
    a, g = jnp.split(y @ w_glu.astype(F32) + b_glu.astype(F32), 2, axis=-1)
    return (a * jax.nn.sigmoid(g)).astype(out_dtype)


def chunk_gmlp(z, norm_g, w_s, b_s):
    b, n, _ = z.shape
    u, v = jnp.split(jax.nn.gelu(z), 2, axis=-1)
    v = layer_norm(v, norm_g).reshape(b, n // GMLP_CHUNK, GMLP_CHUNK, GMLP_GROUPS, GMLP_GROUP_DIM)
    mixed = jnp.einsum('gij,bcjgd->bcigd', w_s, v) + b_s.T[:, :, None]
    return u * mixed.reshape(b, n, GMLP_WIDTH)


def merge_branches(branches, gate_logits, w_branch, w_out):
    gates = jax.nn.sigmoid(gate_logits.astype(F32)).astype(gate_logits.dtype)
    gates = gates.reshape(gate_logits.shape[:-1] + (N_BRANCH, D_MODEL))
    merged = sum(gates[..., i, :] * (y @ w_branch[i]) for i, y in enumerate(branches))
    return merged @ w_out


def token_mix(hl, hc, tab_mla, tab_gqa, lp, need_ctx):
    b, n, _ = hl.shape
    nc = hc.shape[1]
    kvl_l, kpe_l, gk_l, gv_l, u_l, ql_l, gq_l, z_l, gate_l = split_cols(hl @ lp['w_in'], SEG_WIDTHS)
    ctx_widths = SEG_WIDTHS if need_ctx else SEG_WIDTHS[:N_CTX_SEGS]
    parts_c = split_cols(hc @ lp['w_in'][:, :sum(ctx_widths)], ctx_widths)
    kvl_c, kpe_c, gk_c, gv_c, u_c = parts_c[:N_CTX_SEGS]

    mla_scale = (MLA_NOPE + MLA_ROPE) ** -0.5
    k_lat, v_lat = mla_keys_values(kvl_l, kpe_l, lp['mla_kv_norm'], lp['mla_w_ukv'], tab_mla)
    k_ctx, v_ctx = mla_keys_values(kvl_c, kpe_c, lp['mla_kv_norm'], lp['mla_w_ukv'], None)
    q_lat = mla_queries(ql_l, lp['mla_q_norm'], lp['mla_w_uq'], tab_mla)
    a_l = blocked_attention(q_lat, jnp.concatenate([k_lat, k_ctx], axis=1),
                            jnp.concatenate([v_lat, v_ctx], axis=1), mla_scale).reshape(b, n, BRANCH_WIDTH)

    gq_lat = axial_rope(gq_l.reshape(b, n, GQA_Q_HEADS, HEAD_DIM), tab_gqa)
    gk_lat = axial_rope(gk_l.reshape(b, n, GQA_KV_HEADS, HEAD_DIM), tab_gqa)
    gv_lat = gv_l.reshape(b, n, GQA_KV_HEADS, HEAD_DIM)
    gk_ctx = gk_c.reshape(b, nc, GQA_KV_HEADS, HEAD_DIM)
    gv_ctx = gv_c.reshape(b, nc, GQA_KV_HEADS, HEAD_DIM)
    b_l = window_gqa_latent(gq_lat, gk_lat, gv_lat, gk_ctx, gv_ctx, lp['gqa_sink']).reshape(b, n, BRANCH_WIDTH)

    disc_f = s5_discretize(lp['s5_lam_re'][0], lp['s5_lam_im'][0], lp['s5_log_dt'][0], lp['s5_b_re'][0], lp['s5_b_im'][0])
    disc_b = s5_discretize(lp['s5_lam_re'][1], lp['s5_lam_im'][1], lp['s5_log_dt'][1], lp['s5_b_re'][1], lp['s5_b_im'][1])
    uc = u_c.astype(F32).reshape(b, nc, S5_GROUPS, S5_GROUP)
    ul = u_l.astype(F32).reshape(b, n, S5_GROUPS, S5_GROUP)
    fwd_c = s5_states(uc, disc_f, None, False)
    bwd_c = s5_states(uc, disc_b, None, True)
    fwd_l = s5_states(ul, disc_f, (fwd_c[0][:, -1], fwd_c[1][:, -1]), False)
    bwd_l = s5_states(ul, disc_b, (bwd_c[0][:, 0], bwd_c[1][:, 0]), True)
    c_l = s5_output(ul, fwd_l, bwd_l, lp['s5_c_re'], lp['s5_c_im'], lp['s5_d'], lp['s5_w_glu'], lp['s5_b_glu'], hl.dtype)

    d_l = chunk_gmlp(z_l, lp['gmlp_norm'], lp['gmlp_w_s'], lp['gmlp_b_s'])

    yl = merge_branches((a_l, b_l, c_l, d_l), gate_l, lp['w_branch'], lp['w_out'])
    if not need_ctx:
        return yl, None

    ql_c, gq_c, z_c, gate_c = parts_c[N_CTX_SEGS:]
    q_ctx = mla_queries(ql_c, lp['mla_q_norm'], lp['mla_w_uq'], None)
    a_c = blocked_attention(q_ctx, k_ctx, v_ctx, mla_scale).reshape(b, nc, BRANCH_WIDTH)
    b_c = sink_gqa_context(gq_c.reshape(b, nc, GQA_Q_HEADS, HEAD_DIM), gk_ctx, gv_ctx, lp['gqa_sink']).reshape(b, nc, BRANCH_WIDTH)
    c_c = s5_output(uc, fwd_c, bwd_c, lp['s5_c_re'], lp['s5_c_im'], lp['s5_d'], lp['s5_w_glu'], lp['s5_b_glu'], hc.dtype)
    d_c = chunk_gmlp(z_c, lp['gmlp_norm'], lp['gmlp_w_s'], lp['gmlp_b_s'])
    yc = merge_branches((a_c, b_c, c_c, d_c), gate_c, lp['w_branch'], lp['w_out'])
    return yl, yc


def mod_vec(mod, i):
    return mod[:, i][:, None, :]


def modulated_norm(xs, gain, mod, s):
    return rms_norm(xs, gain) * (1.0 + mod_vec(mod, 3 * s + 1)) + mod_vec(mod, 3 * s)


def gated_residual(xs, y, gain, mod, s, weight):
    return xs + weight * mod_vec(mod, 3 * s + 2) * rms_norm(y, gain)


def ffn_sublayer(xs, mod, s, g_pre, g_post, w_in_f, w_out_f):
    a, g = jnp.split(modulated_norm(xs, g_pre, mod, s) @ w_in_f, 2, axis=-1)
    return gated_residual(xs, (jax.nn.silu(a) * g) @ w_out_f, g_post, mod, s, MACARON_WEIGHT)


def setup_inputs(seed: int = 0) -> dict:
    key = jax.random.key(seed)
    keys = iter(jax.random.split(key, 40))

    def nrm(shape, scale):
        return scale * jax.random.normal(next(keys), shape, F32)

    def gain(shape):
        return 1.0 + nrm(shape, 0.05)

    hg, p, g = S5_GROUP, S5_STATE, S5_GROUPS
    lam_im0 = jnp.broadcast_to(jnp.pi * jnp.arange(p, dtype=F32), (DEPTH, 2, g, p))
    return {
        'x': nrm((BATCH, SEQ, D_MODEL), 1.0),
        'c': nrm((BATCH, D_MODEL), 1.0),
        'ctx': nrm((BATCH, CTX_LEN, D_MODEL), 1.0),
        'c_ctx': nrm((D_MODEL,), 1.0),
        'w_ada': nrm((DEPTH, D_MODEL, N_MOD * D_MODEL), D_MODEL ** -0.5),
        'b_ada': nrm((DEPTH, N_MOD * D_MODEL), 0.01),
        'norm_pre': gain((DEPTH, 3, D_MODEL)),
        'norm_post': gain((DEPTH, 3, D_MODEL)),
        'w_ffn_in': nrm((DEPTH, 2, D_MODEL, 2 * D_FF), D_MODEL ** -0.5),
        'w_ffn_out': nrm((DEPTH, 2, D_FF, D_MODEL), D_FF ** -0.5),
        'w_in': nrm((DEPTH, D_MODEL, IN_COLS), D_MODEL ** -0.5),
        'mla_q_norm': gain((DEPTH, MLA_Q_LORA)),
        'mla_w_uq': nrm((DEPTH, MLA_Q_LORA, MLA_HEADS * (MLA_NOPE + MLA_ROPE)), MLA_Q_LORA ** -0.5),
        'mla_kv_norm': gain((DEPTH, MLA_KV_LORA)),
        'mla_w_ukv': nrm((DEPTH, MLA_KV_LORA, MLA_HEADS * (MLA_NOPE + MLA_V)), MLA_KV_LORA ** -0.5),
        'gqa_sink': nrm((DEPTH, GQA_Q_HEADS), 0.5),
        's5_lam_re': -0.5 + nrm((DEPTH, 2, g, p), 0.01),
        's5_lam_im': lam_im0 + nrm((DEPTH, 2, g, p), 0.01),
        's5_log_dt': jax.random.uniform(next(keys), (DEPTH, 2, g), F32, math.log(S5_DT_MIN), math.log(S5_DT_MAX)),
        's5_b_re': nrm((DEPTH, 2, g, p, hg), (2 * hg) ** -0.5),
        's5_b_im': nrm((DEPTH, 2, g, p, hg), (2 * hg) ** -0.5),
        's5_c_re': nrm((DEPTH, 2, g, hg, p), p ** -0.5),
        's5_c_im': nrm((DEPTH, 2, g, hg, p), p ** -0.5),
        's5_d': nrm((DEPTH, S5_CHANNELS), 1.0),
        's5_w_glu': nrm((DEPTH, S5_CHANNELS, 2 * S5_CHANNELS), S5_CHANNELS ** -0.5),
        's5_b_glu': nrm((DEPTH, 2 * S5_CHANNELS), 0.01),
        'gmlp_norm': gain((DEPTH, GMLP_WIDTH)),
        'gmlp_w_s': nrm((DEPTH, GMLP_GROUPS, GMLP_CHUNK, GMLP_CHUNK), 0.5 * GMLP_CHUNK ** -0.5),
        'gmlp_b_s': 1.0 + nrm((DEPTH, GMLP_GROUPS, GMLP_CHUNK), 0.01),
        'w_branch': nrm((DEPTH, N_BRANCH, BRANCH_WIDTH, D_MODEL), BRANCH_WIDTH ** -0.5),
        'w_out': nrm((DEPTH, D_MODEL, D_MODEL), D_MODEL ** -0.5),
    }


def reference(x, c, ctx, c_ctx, w_ada, b_ada, norm_pre, norm_post, w_ffn_in, w_ffn_out, w_in,
              mla_q_norm, mla_w_uq, mla_kv_norm, mla_w_ukv, gqa_sink,
              s5_lam_re, s5_lam_im, s5_log_dt, s5_b_re, s5_b_im, s5_c_re, s5_c_im, s5_d, s5_w_glu, s5_b_glu,
              gmlp_norm, gmlp_w_s, gmlp_b_s, w_branch, w_out):
    b, n, _ = x.shape
    rows = n // GRID_W
    tab_mla = axial_rope_tables(rows, MLA_ROPE)
    tab_gqa = axial_rope_tables(rows, HEAD_DIM)
    silu_c = jax.nn.silu(c)
    silu_cc = jax.nn.silu(c_ctx)[None, :]
    xl, xc = x, ctx
    for l in range(DEPTH):
        last = l == DEPTH - 1
        mod_l = (silu_c @ w_ada[l] + b_ada[l]).reshape(b, N_MOD, D_MODEL)
        n_mod_c = MOD_CTX_LAST if last else N_MOD
        mod_c = (silu_cc @ w_ada[l][:, :n_mod_c * D_MODEL] + b_ada[l][:n_mod_c * D_MODEL]).reshape(1, n_mod_c, D_MODEL)
        lp = dict(w_in=w_in[l], mla_q_norm=mla_q_norm[l], mla_w_uq=mla_w_uq[l],
                  mla_kv_norm=mla_kv_norm[l], mla_w_ukv=mla_w_ukv[l], gqa_sink=gqa_sink[l],
                  s5_lam_re=s5_lam_re[l], s5_lam_im=s5_lam_im[l], s5_log_dt=s5_log_dt[l],
                  s5_b_re=s5_b_re[l], s5_b_im=s5_b_im[l], s5_c_re=s5_c_re[l], s5_c_im=s5_c_im[l],
                  s5_d=s5_d[l], s5_w_glu=s5_w_glu[l], s5_b_glu=s5_b_glu[l],
                  gmlp_norm=gmlp_norm[l], gmlp_w_s=gmlp_w_s[l], gmlp_b_s=gmlp_b_s[l],
                  w_branch=w_branch[l], w_out=w_out[l])
        xl = ffn_sublayer(xl, mod_l, 0, norm_pre[l, 0], norm_post[l, 0], w_ffn_in[l, 0], w_ffn_out[l, 0])
        xc = ffn_sublayer(xc, mod_c, 0, norm_pre[l, 0], norm_post[l, 0], w_ffn_in[l, 0], w_ffn_out[l, 0])
        hl = modulated_norm(xl, norm_pre[l, 1], mod_l, 1)
        hc = modulated_norm(xc, norm_pre[l, 1], mod_c, 1)
        yl, yc = token_mix(hl, hc, tab_mla, tab_gqa, lp, not last)
        xl = gated_residual(xl, yl, norm_post[l, 1], mod_l, 1, 1.0)
        xl = ffn_sublayer(xl, mod_l, 2, norm_pre[l, 2], norm_post[l, 2], w_ffn_in[l, 1], w_ffn_out[l, 1])
        if not last:
            xc = gated_residual(xc, yc, norm_post[l, 1], mod_c, 1, 1.0)
            xc = ffn_sublayer(xc, mod_c, 2, norm_pre[l, 2], norm_post[l, 2], w_ffn_in[l, 1], w_ffn_out[l, 1])
    return xl
```

```cpp
#include <hip/hip_runtime.h>
#include <hip/hip_bf16.h>
#include <hip/hip_cooperative_groups.h>
#include <cstdio>
namespace cg = cooperative_groups;

#ifndef EMASK
#define EMASK 0x7fff
#endif
#ifndef COOP
#define COOP 1
#endif

using bf16 = __hip_bfloat16;
typedef short bf16x8 __attribute__((ext_vector_type(8)));
typedef float f32x4 __attribute__((ext_vector_type(4)));
typedef unsigned short us4 __attribute__((ext_vector_type(4)));
#define DEV __device__ __forceinline__

constexpr int T = 18432, TL = 16384, INP = 5888, NKEY = 2304;
constexpr int C_KVL = 0, C_KPE = 128, C_GK = 160, C_GV = 288, C_U = 416, C_QL = 672, C_GQ = 928, C_Z = 1184, C_GATE = 1696;
constexpr int LDS_BYTES = 131072;

constexpr size_t O_WFI = 0;
constexpr size_t O_WFO = O_WFI + 23068672;
constexpr size_t O_WIN = O_WFO + 11534336;
constexpr size_t O_WBR = O_WIN + 12058624;
constexpr size_t O_WOUT = O_WBR + 2097152;
constexpr size_t O_WUQ = O_WOUT + 2097152;
constexpr size_t O_WUKV = O_WUQ + 196608;
constexpr size_t O_WGLU = O_WUKV + 131072;
constexpr size_t O_WSP = O_WGLU + 262144;
constexpr size_t O_MOD = O_WSP + 131072;
constexpr size_t O_X = O_MOD + 1327104;
constexpr size_t O_H = O_X + 75497472;
constexpr size_t O_PROJ = O_H + 37748736;
constexpr size_t O_Y = O_PROJ + 217055232;
constexpr size_t O_MRG = O_Y + 75497472;
constexpr size_t O_GQ = O_MRG + 37748736;
constexpr size_t O_GK = O_GQ + 9437184;
constexpr size_t O_GVT = O_GK + 4718592;
constexpr size_t O_END = O_GVT + 4718592;
constexpr size_t O_KMLA = O_MRG, O_VTMLA = O_MRG + 14155776, O_QMLA = O_VTMLA + 9437184;

struct Params {
  const float* in[31];
  float* out;
  unsigned char* ws;
  int lo, hi;
};

DEV unsigned short f2bf(float f) { unsigned u = __float_as_uint(f); u += 0x7fffu + ((u >> 16) & 1u); return (unsigned short)(u >> 16); }
DEV float bf2f(unsigned short h) { return __uint_as_float(((unsigned)h) << 16); }
DEV float bfs2f(short h) { return __uint_as_float(((unsigned)(unsigned short)h) << 16); }
DEV us4 pack4(float a, float b, float c, float d) { us4 r; r[0] = f2bf(a); r[1] = f2bf(b); r[2] = f2bf(c); r[3] = f2bf(d); return r; }
DEV bf16x8 ldg8(const bf16* p) { return *reinterpret_cast<const bf16x8*>(p); }
DEV us4 ldg4(const bf16* p) { return *reinterpret_cast<const us4*>(p); }
DEV void stg4(bf16* p, us4 v) { *reinterpret_cast<us4*>(p) = v; }
DEV float shx(float v, int mask, int lane) { return __int_as_float(__builtin_amdgcn_ds_bpermute((lane ^ mask) << 2, __float_as_int(v))); }
DEV float wave_sum(float v, int lane) {
#pragma unroll
  for (int o = 32; o > 0; o >>= 1) v += shx(v, o, lane);
  return v; }
DEV float sigmoidf_(float x) { return 1.f / (1.f + __expf(-x)); }
DEV float siluf_(float x) { return x / (1.f + __expf(-x)); }
DEV float geluf_(float x) { float u = 0.7978845608028654f * (x + 0.044715f * x * x * x); float e = __expf(2.f * u); return x * (1.f - 1.f / (1.f + e)); }
DEV int opaque_tid() { int t; asm volatile("v_mov_b32 %0, %1" : "=v"(t) : "v"((int)threadIdx.x)); return t; }
DEV f32x4 mfma16(bf16x8 a, bf16x8 b, f32x4 c) { return __builtin_amdgcn_mfma_f32_16x16x32_bf16(a, b, c, 0, 0, 0); }

DEV void sincos_acc(float x, float& s, float& c) {
  float kf = rintf(x * 0.636619772367581f);
  int k = (int)kf;
  float r = fmaf(-kf, 1.5703125f, x);
  r = fmaf(-kf, 4.837512969970703125e-4f, r);
  r = fmaf(-kf, 7.54978995489188216e-8f, r);
  float r2 = r * r;
  float sp = r + r * r2 * (-1.6666667163e-01f + r2 * (8.3333337680e-03f + r2 * (-1.9841270114e-04f + r2 * 2.7557314297e-06f)));
  float cp = 1.0f + r2 * (-0.5f + r2 * (4.1666667908e-02f + r2 * (-1.3888889225e-03f + r2 * 2.4801587642e-05f)));
  int q = k & 3;
  s = (q == 0) ? sp : (q == 1) ? cp : (q == 2) ? -sp : -cp;
  c = (q == 0) ? cp : (q == 1) ? -sp : (q == 2) ? -cp : sp;
}
DEV float rope1(float x, float xp, bool is_x2, float pos, int fi, float nf) {
  float freq = exp2f(-13.287712379549449f * (float)fi / nf);
  float s, c; sincos_acc(pos * freq, s, c);
  return is_x2 ? x * c + xp * s : x * c - xp * s;
}

DEV int lds_byte(int r, int c) {
  int st = (r >> 4) * 2 + (c >> 5), rr = r & 15, cc = c & 31, ob = rr * 64 + cc * 2;
  return st * 1024 + (ob ^ (((ob >> 9) & 1) << 5));
}
DEV void stage_rc(int b, int& R, int& C) {
  int st = b / 1024, sb = b % 1024, swz = sb ^ (((sb >> 9) & 1) << 5);
  R = (st >> 1) * 16 + swz / 64; C = (st & 1) * 32 + (swz % 64) / 2;
}

template <class Epi>
DEV void gemm_tile(const bf16* __restrict__ A, int lda, const bf16* __restrict__ Bt, int ldb, int K, int brow, int bcol, Epi& epi) {
  const int tidx_ = opaque_tid();
  extern __shared__ __attribute__((aligned(16))) unsigned char smem[];
  bf16* shm = reinterpret_cast<bf16*>(smem);
  constexpr int BK = 64, HALF = 128, HT = HALF * BK;
#define SA(b, h) (shm + ((b) * 2 + (h)) * HT)
#define SB(b, h) (shm + (4 + (b) * 2 + (h)) * HT)
#define STAGE(P, BASE, LD, br, kt) do { const bf16* _gb = BASE + ((long)(br) * (LD) + (long)(kt) * BK); \
    _Pragma("unroll") for (int _i = 0; _i < 2; ++_i) { \
      __builtin_amdgcn_global_load_lds((const unsigned*)(_gb + ((&LD == &lda) ? offA[_i] : offB[_i])), \
        (unsigned*)((char*)(P) + tidx_ * 16 + _i * 8192), 16, 0, 0); } } while (0)
#define LDA(dst, b, h) _Pragma("unroll") for (int m = 0; m < 4; ++m) _Pragma("unroll") for (int k = 0; k < 2; ++k) \
    dst[m][k] = *reinterpret_cast<const bf16x8*>((char*)SA(b, h) + lds_byte(wr * 64 + m * 16 + fr, k * 32 + fq * 8))
#define LDB(dst, b, h) _Pragma("unroll") for (int n = 0; n < 2; ++n) _Pragma("unroll") for (int k = 0; k < 2; ++k) \
    dst[n][k] = *reinterpret_cast<const bf16x8*>((char*)SB(b, h) + lds_byte(wc * 32 + n * 16 + fr, k * 32 + fq * 8))
#define MMA(ai, bj, At_, Bt_) do { __builtin_amdgcn_s_setprio(1); \
    _Pragma("unroll") for (int m = 0; m < 4; ++m) _Pragma("unroll") for (int n = 0; n < 2; ++n) _Pragma("unroll") for (int k = 0; k < 2; ++k) \
      acc[ai][bj][m][n] = __builtin_amdgcn_mfma_f32_16x16x32_bf16(Bt_[n][k], At_[m][k], acc[ai][bj][m][n], 0, 0, 0); \
    __builtin_amdgcn_s_setprio(0); } while (0)
#define WAIT_V(n) asm volatile("s_waitcnt vmcnt(" #n ")" ::: "memory")
#define WAIT_L(n) asm volatile("s_waitcnt lgkmcnt(" #n ")" ::: "memory")
#define BAR __builtin_amdgcn_s_barrier()
#define SCHED __builtin_amdgcn_sched_barrier(0)
  const int wid = __builtin_amdgcn_readfirstlane(tidx_ >> 6), lane = tidx_ & 63, wr = wid >> 2, wc = wid & 3, fr = lane & 15, fq = lane >> 4;
  f32x4 acc[2][2][4][2] = {};
  bf16x8 At[4][2], B0[2][2], B1[2][2];
  const int nt = K / BK;
  unsigned offA[2], offB[2];
#pragma unroll
  for (int _i = 0; _i < 2; ++_i) { int _r, _c; stage_rc(tidx_ * 16 + _i * 8192, _r, _c); offA[_i] = (unsigned)(_r * lda + _c); offB[_i] = (unsigned)(_r * ldb + _c); }
  STAGE(SB(0, 0), Bt, ldb, bcol, 0); STAGE(SA(0, 0), A, lda, brow, 0);
  STAGE(SB(0, 1), Bt, ldb, bcol + HALF, 0); STAGE(SA(0, 1), A, lda, brow + HALF, 0);
  if (wr == 1) BAR;
  WAIT_V(4); BAR;
  STAGE(SB(1, 0), Bt, ldb, bcol, 1); STAGE(SA(1, 0), A, lda, brow, 1); STAGE(SB(1, 1), Bt, ldb, bcol + HALF, 1);
  WAIT_V(6); BAR;
  for (int t = 0; t < nt - 2; t += 2) {
    LDB(B0, 0, 0); SCHED; LDA(At, 0, 0); STAGE(SA(1, 1), A, lda, brow + HALF, t + 1);
    WAIT_L(8); BAR; WAIT_L(0); MMA(0, 0, At, B0); BAR; SCHED;
    LDB(B1, 0, 1); STAGE(SB(0, 0), Bt, ldb, bcol, t + 2);
    BAR; WAIT_L(0); MMA(0, 1, At, B1); BAR;
    LDA(At, 0, 1); STAGE(SA(0, 0), A, lda, brow, t + 2);
    BAR; WAIT_L(0); MMA(1, 0, At, B0); BAR; SCHED;
    STAGE(SB(0, 1), Bt, ldb, bcol + HALF, t + 2);
    WAIT_V(6); BAR; MMA(1, 1, At, B1); BAR;
    LDB(B0, 1, 0); SCHED; LDA(At, 1, 0); STAGE(SA(0, 1), A, lda, brow + HALF, t + 2);
    WAIT_L(8); BAR; WAIT_L(0); MMA(0, 0, At, B0); BAR; SCHED;
    LDB(B1, 1, 1); STAGE(SB(1, 0), Bt, ldb, bcol, t + 3);
    BAR; WAIT_L(0); MMA(0, 1, At, B1); BAR;
    LDA(At, 1, 1); STAGE(SA(1, 0), A, lda, brow, t + 3);
    BAR; WAIT_L(0); MMA(1, 0, At, B0); BAR; SCHED;
    STAGE(SB(1, 1), Bt, ldb, bcol + HALF, t + 3);
    WAIT_V(6); BAR; MMA(1, 1, At, B1); BAR;
  }
  { LDB(B0, 0, 0); LDA(At, 0, 0); STAGE(SA(1, 1), A, lda, brow + HALF, nt - 1);
    BAR; WAIT_L(0); MMA(0, 0, At, B0); BAR;
    LDB(B1, 0, 1); BAR; WAIT_L(0); MMA(0, 1, At, B1); BAR;
    LDA(At, 0, 1); WAIT_V(4); BAR; WAIT_L(0); MMA(1, 0, At, B0); MMA(1, 1, At, B1); BAR; }
  { LDB(B0, 1, 0); LDA(At, 1, 0); WAIT_V(2); BAR; WAIT_L(0); MMA(0, 0, At, B0); BAR;
    LDB(B1, 1, 1); WAIT_V(0); BAR; WAIT_L(0); MMA(0, 1, At, B1); BAR;
    LDA(At, 1, 1); BAR; WAIT_L(0); MMA(1, 0, At, B0); MMA(1, 1, At, B1); BAR; }
  if (wr == 0) BAR;
#pragma unroll
  for (int ai = 0; ai < 2; ++ai)
#pragma unroll
    for (int bj = 0; bj < 2; ++bj)
#pragma unroll
      for (int m = 0; m < 4; ++m)
      { epi(brow + ai * HALF + wr * 64 + m * 16 + fr, bcol + bj * HALF + wc * 32, fq, acc[ai][bj][m][0], acc[ai][bj][m][1]); __builtin_amdgcn_sched_barrier(0); }
#undef SA
#undef SB
#undef STAGE
#undef LDA
#undef LDB
#undef MMA
}

DEV int vblock() { const int G = gridDim.x, bx = blockIdx.x; return (G % 8 == 0) ? (bx % 8) * (G / 8) + bx / 8 : bx; }

DEV void tile_of(int t, int nM, int nN, int& pm, int& pn) {
  int nig = 8 * nN, gid = t / nig, fm = gid * 8, gsz = min(nM - fm, 8);
  pm = fm + (t % nig) % gsz; pn = (t % nig) / gsz;
}

template <class Epi>
DEV void gemm_phase(const bf16* A, int lda, const bf16* Bt, int ldb, int M, int N, int K, Epi epi) {
  const int nM = M / 256, nN = N / 256, ntile = nM * nN;
  for (int t = vblock(); t < ntile; t += gridDim.x) {
    int pm, pn; tile_of(t, nM, nN, pm, pn);
    gemm_tile(A, lda, Bt, ldb, K, pm * 256, pn * 256, epi);
  }
}

struct EpiSwiglu {
  bf16* h1;
  DEV void operator()(int row, int colbase, int fq, f32x4 a, f32x4 g) const {
    us4 o = pack4(siluf_(a[0]) * g[0], siluf_(a[1]) * g[1], siluf_(a[2]) * g[2], siluf_(a[3]) * g[3]);
    stg4(h1 + (size_t)row * 2816 + (colbase >> 1) + fq * 4, o);
  }
};
struct EpiF32 {
  float* out; static constexpr int ld = 1024;
  DEV void operator()(int row, int colbase, int fq, f32x4 a0, f32x4 a1) const {
    float* p = out + (size_t)row * ld + colbase + fq * 4;
    *reinterpret_cast<f32x4*>(p) = a0; *reinterpret_cast<f32x4*>(p + 16) = a1;
  }
};
struct EpiBf16 {
  bf16* out; static constexpr int ld = INP;
  DEV void operator()(int row, int colbase, int fq, f32x4 a0, f32x4 a1) const {
    bf16* p = out + (size_t)row * ld + colbase + fq * 4;
    stg4(p, pack4(a0[0], a0[1], a0[2], a0[3])); stg4(p + 16, pack4(a1[0], a1[1], a1[2], a1[3]));
  }
};
template <int i> struct EpiBranch {
  const bf16* proj; float* mbuf; bf16* merged;
  DEV void one(int row, int col, f32x4 a) const {
    us4 gr = ldg4(proj + (size_t)row * INP + C_GATE + i * 1024 + col);
    f32x4 v;
    for (int r = 0; r < 4; ++r) v[r] = sigmoidf_(bf2f(gr[r])) * a[r];
    float* mp = mbuf + (size_t)row * 1024 + col;
    if (i > 0) { f32x4 o = *reinterpret_cast<f32x4*>(mp); v += o; }
    if (i < 3) *reinterpret_cast<f32x4*>(mp) = v;
    else stg4(merged + (size_t)row * 1024 + col, pack4(v[0], v[1], v[2], v[3]));
  }
  DEV void operator()(int row, int colbase, int fq, f32x4 a0, f32x4 a1) const {
    one(row, colbase + fq * 4, a0); one(row, colbase + 16 + fq * 4, a1);
  }
};

DEV void mod_phase(const Params& p) {
  const int tidx_ = opaque_tid();
  extern __shared__ __attribute__((aligned(16))) unsigned char smem[];
  float* sl = reinterpret_cast<float*>(smem);
  float* part = sl + 9 * 1024;
  const int tid = tidx_;
  const float* c = p.in[1]; const float* cc = p.in[3]; const float* w_ada = p.in[4]; const float* b_ada = p.in[5];
  float* MOD = reinterpret_cast<float*>(p.ws + O_MOD);
  for (int i = tid; i < 9 * 1024; i += 512) { int r = i >> 10, k = i & 1023; float v = r < 8 ? c[r * 1024 + k] : cc[k]; sl[i] = v / (1.f + __expf(-v)); }
  __syncthreads();
  for (int item = blockIdx.x; item < 576; item += gridDim.x) {
    const int l = item / 144, n0 = (item % 144) * 64;
    const int cq = tid & 15, kg = tid >> 4;
    const float* w = w_ada + (size_t)l * 1024 * 9216 + n0 + cq * 4;
    float acc[9][4];
#pragma unroll
    for (int r = 0; r < 9; ++r) for (int e = 0; e < 4; ++e) acc[r][e] = 0.f;
#pragma unroll 4
    for (int kk = 0; kk < 32; ++kk) {
      const int k = kg * 32 + kk;
      f32x4 wv = *reinterpret_cast<const f32x4*>(w + (size_t)k * 9216);
#pragma unroll
      for (int r = 0; r < 9; ++r) { float s = sl[r * 1024 + k];
#pragma unroll
        for (int e = 0; e < 4; ++e) acc[r][e] = fmaf(s, wv[e], acc[r][e]); }
    }
#pragma unroll
    for (int r = 0; r < 9; ++r)
#pragma unroll
      for (int e = 0; e < 4; ++e) part[(kg * 9 + r) * 64 + cq * 4 + e] = acc[r][e];
    __syncthreads();
    for (int o = tid; o < 576; o += 512) {
      int r = o >> 6, col = o & 63; float s = 0.f;
      for (int g = 0; g < 32; ++g) s += part[(g * 9 + r) * 64 + col];
      MOD[(size_t)l * 9 * 9216 + (size_t)r * 9216 + n0 + col] = s + b_ada[l * 9216 + n0 + col];
    }
    __syncthreads();
  }
}

DEV void conv_T(const float* __restrict__ src, int K, int N, bf16* __restrict__ dst, int Npad, int mapmode, int rot) {
  const int tidx_ = opaque_tid();
  extern __shared__ __attribute__((aligned(16))) unsigned char smem[];
  float* tl = reinterpret_cast<float*>(smem);
  const int tid = tidx_, G = gridDim.x;
  const int nk = K / 64, nn = Npad / 64, ntiles = nk * nn;
  for (int tile = (blockIdx.x + rot) % G; tile < ntiles; tile += G) {
    const int kt = tile % nk, ntile = tile / nk, k0 = kt * 64, n0 = ntile * 64;
#pragma unroll
    for (int i = 0; i < 8; ++i) { int idx = tid + i * 512, r = idx >> 6, cc = idx & 63, n = n0 + cc;
      tl[r * 65 + cc] = n < N ? src[(size_t)(k0 + r) * N + n] : 0.f; }
    __syncthreads();
#pragma unroll
    for (int i = 0; i < 4; ++i) { int pidx = tid + i * 512, rn = pidx >> 5, ck = (pidx & 31) * 2, n = n0 + rn;
      int dr = n;
      if (mapmode == 1) { int j = n < 2816 ? n : n - 2816; dr = (j >> 4) * 32 + (j & 15) + (n < 2816 ? 0 : 16); }
      unsigned v = (unsigned)f2bf(tl[ck * 65 + rn]) | ((unsigned)f2bf(tl[(ck + 1) * 65 + rn]) << 16);
      *reinterpret_cast<unsigned*>(dst + (size_t)dr * K + k0 + ck) = v; }
    __syncthreads();
  }
}

DEV void conv_phase(const Params& p, int l) {
  const int tidx_ = opaque_tid();
  unsigned char* ws = p.ws;
  for (int j = 0; j < 2; ++j) {
    conv_T(p.in[8] + (size_t)(l * 2 + j) * 1024 * 5632, 1024, 5632, reinterpret_cast<bf16*>(ws + O_WFI) + (size_t)j * 5632 * 1024, 5632, 1, j * 128);
    conv_T(p.in[9] + (size_t)(l * 2 + j) * 2816 * 1024, 2816, 1024, reinterpret_cast<bf16*>(ws + O_WFO) + (size_t)j * 1024 * 2816, 1024, 0, j * 192 + 64);
  }
  conv_T(p.in[10] + (size_t)l * 1024 * 5792, 1024, 5792, reinterpret_cast<bf16*>(ws + O_WIN), 5888, 0, 192);
  for (int i = 0; i < 4; ++i)
    conv_T(p.in[29] + (size_t)(l * 4 + i) * 256 * 1024, 256, 1024, reinterpret_cast<bf16*>(ws + O_WBR) + (size_t)i * 1024 * 256, 1024, 0, i * 64);
  conv_T(p.in[30] + (size_t)l * 1024 * 1024, 1024, 1024, reinterpret_cast<bf16*>(ws + O_WOUT), 1024, 0, 0);
  conv_T(p.in[12] + (size_t)l * 256 * 384, 256, 384, reinterpret_cast<bf16*>(ws + O_WUQ), 384, 0, 0);
  conv_T(p.in[14] + (size_t)l * 128 * 512, 128, 512, reinterpret_cast<bf16*>(ws + O_WUKV), 512, 0, 24);
  conv_T(p.in[24] + (size_t)l * 256 * 512, 256, 512, reinterpret_cast<bf16*>(ws + O_WGLU), 512, 0, 40);
  { const float* src = p.in[27] + (size_t)l * 65536; bf16* dst = reinterpret_cast<bf16*>(ws + O_WSP);
    for (int i = blockIdx.x * 512 + tidx_; i < 65536; i += gridDim.x * 512) reinterpret_cast<unsigned short*>(dst)[i] = f2bf(src[i]); }
}

DEV void e_phase(const Params& p, int l, int mode) {
  const int tidx_ = opaque_tid();
  float* X = reinterpret_cast<float*>(p.ws + O_X);
  const float* Y = reinterpret_cast<const float*>(p.ws + O_Y);
  bf16* H = reinterpret_cast<bf16*>(p.ws + O_H);
  const float* MOD = reinterpret_cast<const float*>(p.ws + O_MOD);
  const float* npre = p.in[6]; const float* npost = p.in[7];
  const int lane = tidx_ & 63, wv = __builtin_amdgcn_readfirstlane(tidx_ >> 6);
  for (int t = blockIdx.x * 8 + wv; t < T; t += gridDim.x * 8) {
    const int mi = t < TL ? (t >> 11) : 8;
    f32x4 xv[4];
    if (mode == 0) {
      const float* src = t < TL ? p.in[0] + (size_t)t * 1024 : p.in[2] + (size_t)(t - TL) * 1024;
#pragma unroll
      for (int i = 0; i < 4; ++i) xv[i] = *reinterpret_cast<const f32x4*>(src + i * 256 + lane * 4);
#pragma unroll
      for (int i = 0; i < 4; ++i) *reinterpret_cast<f32x4*>(X + (size_t)t * 1024 + i * 256 + lane * 4) = xv[i];
    } else {
      f32x4 yv[4]; float ss = 0.f;
#pragma unroll
      for (int i = 0; i < 4; ++i) { xv[i] = *reinterpret_cast<const f32x4*>(X + (size_t)t * 1024 + i * 256 + lane * 4);
        yv[i] = *reinterpret_cast<const f32x4*>(Y + (size_t)t * 1024 + i * 256 + lane * 4);
        ss += yv[i][0] * yv[i][0] + yv[i][1] * yv[i][1] + yv[i][2] * yv[i][2] + yv[i][3] * yv[i][3]; }
      ss = wave_sum(ss, lane);
      const float rstd = rsqrtf(ss * (1.f / 1024.f) + 1e-6f);
      const int sp = mode - 1; const float wgt = (sp == 1) ? 1.f : 0.5f;
      const float* gate = MOD + (size_t)l * 9 * 9216 + (size_t)mi * 9216 + (3 * sp + 2) * 1024;
      const float* gp = npost + (l * 3 + sp) * 1024;
#pragma unroll
      for (int i = 0; i < 4; ++i) { const int c0 = i * 256 + lane * 4;
        f32x4 gt = *reinterpret_cast<const f32x4*>(gate + c0); f32x4 gg = *reinterpret_cast<const f32x4*>(gp + c0);
#pragma unroll
        for (int e = 0; e < 4; ++e) xv[i][e] += wgt * gt[e] * (yv[i][e] * rstd * gg[e]);
        *reinterpret_cast<f32x4*>(X + (size_t)t * 1024 + c0) = xv[i]; }
    }
    if (mode == 3 && l == 3) {
      if (t < TL) {
#pragma unroll
        for (int i = 0; i < 4; ++i) *reinterpret_cast<f32x4*>(p.out + (size_t)t * 1024 + i * 256 + lane * 4) = xv[i];
      }
      continue;
    }
    const int ln = (mode == 3) ? l + 1 : l; const int s = (mode == 3) ? 0 : mode;
    float ss = 0.f;
#pragma unroll
    for (int i = 0; i < 4; ++i) ss += xv[i][0] * xv[i][0] + xv[i][1] * xv[i][1] + xv[i][2] * xv[i][2] + xv[i][3] * xv[i][3];
    ss = wave_sum(ss, lane);
    const float rstd = rsqrtf(ss * (1.f / 1024.f) + 1e-6f);
    const float* gpre = npre + (ln * 3 + s) * 1024;
    const float* mrow = MOD + (size_t)ln * 9 * 9216 + (size_t)mi * 9216;
#pragma unroll
    for (int i = 0; i < 4; ++i) { const int c0 = i * 256 + lane * 4;
      f32x4 gg = *reinterpret_cast<const f32x4*>(gpre + c0);
      f32x4 sh = *reinterpret_cast<const f32x4*>(mrow + (3 * s) * 1024 + c0);
      f32x4 sc = *reinterpret_cast<const f32x4*>(mrow + (3 * s + 1) * 1024 + c0);
      float o[4];
#pragma unroll
      for (int e = 0; e < 4; ++e) o[e] = xv[i][e] * rstd * gg[e] * (1.f + sc[e]) + sh[e];
      stg4(H + (size_t)t * 1024 + c0, pack4(o[0], o[1], o[2], o[3])); }
  }
}

template <int KS>
DEV void load_norm_frags(const bf16* rowptr, const float* gain, bf16x8 (&fr)[KS], int fq, int lane) {
  float v[KS][8]; float ss = 0.f;
#pragma unroll
  for (int kk = 0; kk < KS; ++kk) { bf16x8 raw = ldg8(rowptr + kk * 32 + fq * 8);
#pragma unroll
    for (int e = 0; e < 8; ++e) { v[kk][e] = bfs2f(raw[e]); ss += v[kk][e] * v[kk][e]; } }
  ss += shx(ss, 16, lane); ss += shx(ss, 32, lane);
  const float rstd = rsqrtf(ss * (1.f / (KS * 32)) + 1e-6f);
#pragma unroll
  for (int kk = 0; kk < KS; ++kk)
#pragma unroll
    for (int e = 0; e < 8; ++e) fr[kk][e] = (short)f2bf(v[kk][e] * rstd * gain[kk * 32 + fq * 8 + e]);
}

DEV void m1_phase(const Params& p, int l) {
  const int tidx_ = opaque_tid();
  unsigned char* ws = p.ws;
  const bf16* PROJ = reinterpret_cast<const bf16*>(ws + O_PROJ);
  bf16* KMLA = reinterpret_cast<bf16*>(ws + O_KMLA); bf16* VTMLA = reinterpret_cast<bf16*>(ws + O_VTMLA); bf16* QMLA = reinterpret_cast<bf16*>(ws + O_QMLA);
  bf16* GQ = reinterpret_cast<bf16*>(ws + O_GQ); bf16* GK = reinterpret_cast<bf16*>(ws + O_GK); bf16* GVT = reinterpret_cast<bf16*>(ws + O_GVT);
  const bf16* WUQ = reinterpret_cast<const bf16*>(ws + O_WUQ); const bf16* WUKV = reinterpret_cast<const bf16*>(ws + O_WUKV);
  const float* qn = p.in[11] + l * 256; const float* kvn = p.in[13] + l * 128;
  const int wv = __builtin_amdgcn_readfirstlane(tidx_ >> 6);
  for (int tile = blockIdx.x * 8 + wv; tile < T / 16; tile += gridDim.x * 8) {
    const int lane = opaque_tid() & 63, fr = lane & 15, fq = lane >> 4;
    const int t0 = tile * 16; const bool lat = t0 < TL;
    const int b = lat ? (t0 >> 11) : ((t0 - TL) >> 8);
    const int pos0 = lat ? (t0 & 2047) : 2048 + ((t0 - TL) & 255);
    const bf16* prow = PROJ + (size_t)(t0 + fr) * INP;
    {
      bf16x8 af[4]; load_norm_frags<4>(prow + C_KVL, kvn, af, fq, lane);
      for (int h = 0; h < 4; ++h) {
        for (int nt = 0; nt < 4; ++nt) {
          f32x4 acc = {0.f, 0.f, 0.f, 0.f};
#pragma unroll
          for (int kk = 0; kk < 4; ++kk) acc = mfma16(ldg8(WUKV + (size_t)(h * 128 + nt * 16 + fr) * 128 + kk * 32 + fq * 8), af[kk], acc);
          stg4(KMLA + ((size_t)(b * 4 + h) * NKEY + pos0 + fr) * 96 + nt * 16 + fq * 4, pack4(acc[0], acc[1], acc[2], acc[3]));
        }
        for (int nt = 0; nt < 4; ++nt) {
          f32x4 acc = {0.f, 0.f, 0.f, 0.f};
#pragma unroll
          for (int kk = 0; kk < 4; ++kk) acc = mfma16(af[kk], ldg8(WUKV + (size_t)(h * 128 + 64 + nt * 16 + fr) * 128 + kk * 32 + fq * 8), acc);
          stg4(VTMLA + ((size_t)(b * 4 + h) * 64 + nt * 16 + fr) * NKEY + pos0 + fq * 4, pack4(acc[0], acc[1], acc[2], acc[3]));
        }
      }
    }
    {
      const int tk = lane >> 2, part = lane & 3;
      const bf16* src = PROJ + (size_t)(t0 + tk) * INP + C_KPE;
      bf16x8 raw = ldg8(src + part * 8), rawp = ldg8(src + (part ^ 1) * 8);
      bf16x8 o = raw;
      if (lat) {
        const int pos = pos0 + tk; const float pa = (float)((part < 2) ? (pos >> 6) : (pos & 63));
#pragma unroll
        for (int e = 0; e < 8; ++e) o[e] = (short)f2bf(rope1(bfs2f(raw[e]), bfs2f(rawp[e]), (part & 1) != 0, pa, e, 8.f));
      }
      for (int h = 0; h < 4; ++h)
        *reinterpret_cast<bf16x8*>(KMLA + ((size_t)(b * 4 + h) * NKEY + pos0 + tk) * 96 + 64 + part * 8) = o;
    }
    {
      bf16x8 qf[8]; load_norm_frags<8>(prow + C_QL, qn, qf, fq, lane);
      for (int h = 0; h < 4; ++h) {
        for (int nt = 0; nt < 6; ++nt) {
          f32x4 acc = {0.f, 0.f, 0.f, 0.f};
#pragma unroll
          for (int kk = 0; kk < 8; ++kk) acc = mfma16(ldg8(WUQ + (size_t)(h * 96 + nt * 16 + fr) * 256 + kk * 32 + fq * 8), qf[kk], acc);
          if (nt >= 4 && lat) {
            const int pos = pos0 + fr; const float pa = (float)((nt == 4) ? (pos >> 6) : (pos & 63));
            f32x4 o;
#pragma unroll
            for (int r = 0; r < 4; ++r) { float xp = shx(acc[r], 32, lane); o[r] = rope1(acc[r], xp, fq >= 2, pa, (fq & 1) * 4 + r, 8.f); }
            acc = o;
          }
          stg4(QMLA + (size_t)(t0 + fr) * 384 + h * 96 + nt * 16 + fq * 4, pack4(acc[0], acc[1], acc[2], acc[3]));
        }
      }
    }
    for (int it = 0; it < 8; ++it) {
      const int ci = lane + it * 64, tk = ci >> 5, c = ci & 31, head = c >> 3, cc = c & 7;
      const bf16* src = PROJ + (size_t)(t0 + tk) * INP + C_GQ + head * 64;
      bf16x8 raw = ldg8(src + cc * 8), rawp = ldg8(src + (cc ^ 2) * 8), o = raw;
      if (lat) { const int pos = pos0 + tk; const float pa = (float)((cc < 4) ? (pos >> 6) : (pos & 63));
#pragma unroll
        for (int e = 0; e < 8; ++e) o[e] = (short)f2bf(rope1(bfs2f(raw[e]), bfs2f(rawp[e]), (cc & 2) != 0, pa, (cc & 1) * 8 + e, 16.f)); }
      *reinterpret_cast<bf16x8*>(GQ + (size_t)(t0 + tk) * 256 + head * 64 + cc * 8) = o;
    }
    for (int it = 0; it < 4; ++it) {
      const int ci = lane + it * 64, tk = ci >> 4, c = ci & 15, kvh = c >> 3, cc = c & 7;
      const bf16* src = PROJ + (size_t)(t0 + tk) * INP + C_GK + kvh * 64;
      bf16x8 raw = ldg8(src + cc * 8), rawp = ldg8(src + (cc ^ 2) * 8), o = raw;
      if (lat) { const int pos = pos0 + tk; const float pa = (float)((cc < 4) ? (pos >> 6) : (pos & 63));
#pragma unroll
        for (int e = 0; e < 8; ++e) o[e] = (short)f2bf(rope1(bfs2f(raw[e]), bfs2f(rawp[e]), (cc & 2) != 0, pa, (cc & 1) * 8 + e, 16.f)); }
      *reinterpret_cast<bf16x8*>(GK + ((size_t)(b * 2 + kvh) * NKEY + pos0 + tk) * 64 + cc * 8) = o;
    }
    for (int it = 0; it < 2; ++it) {
      const int ch = lane + it * 64, kvh = ch >> 6, d = ch & 63;
      const unsigned short* src = reinterpret_cast<const unsigned short*>(PROJ) + (size_t)t0 * INP + C_GV + ch;
      bf16x8 o0, o1;
#pragma unroll
      for (int k = 0; k < 8; ++k) { o0[k] = (short)src[(size_t)k * INP]; o1[k] = (short)src[(size_t)(k + 8) * INP]; }
      bf16* dst = GVT + ((size_t)(b * 2 + kvh) * 64 + d) * NKEY + pos0;
      *reinterpret_cast<bf16x8*>(dst) = o0; *reinterpret_cast<bf16x8*>(dst + 8) = o1;
    }
  }
}

template <int KS>
DEV void attn_wave(const bf16* Q, int ldq, const bf16* Kb, const bf16* Vt, int a_lo, int a_hi, int b_lo, int b_hi, bool maskA, int qpos0,
                   float scale, bool has_sink, float sink, bf16* out, int ldo) {
  const int tidx_ = opaque_tid();
  constexpr int DK = KS * 32;
  const int lane = tidx_ & 63, fr = lane & 15, fq = lane >> 4;
  const float L2E = 1.4426950408889634f;
  bf16x8 qf[2][KS];
#pragma unroll
  for (int qi = 0; qi < 2; ++qi)
#pragma unroll
    for (int kk = 0; kk < KS; ++kk) qf[qi][kk] = ldg8(Q + (size_t)(qi * 16 + fr) * ldq + kk * 32 + fq * 8);
  f32x4 O[2][4];
  float mrun[2], lrun[2];
#pragma unroll
  for (int qi = 0; qi < 2; ++qi) { mrun[qi] = has_sink ? sink : -1e30f; lrun[qi] = (has_sink && fq == 0) ? 1.f : 0.f;
#pragma unroll
    for (int dt = 0; dt < 4; ++dt) O[qi][dt] = (f32x4){0.f, 0.f, 0.f, 0.f}; }
  const int nA = a_hi - a_lo, nB = b_hi - b_lo;
  for (int it = 0; it < nA + nB; ++it) {
    const int c = it < nA ? a_lo + it : b_lo + (it - nA);
    const bool masked = maskA && (it < nA);
    const int key0 = c * 32;
    bf16x8 kf[2][KS];
#pragma unroll
    for (int kt = 0; kt < 2; ++kt)
#pragma unroll
      for (int kk = 0; kk < KS; ++kk) kf[kt][kk] = ldg8(Kb + (size_t)(key0 + kt * 16 + fr) * DK + kk * 32 + fq * 8);
    bf16x8 vf[4];
#pragma unroll
    for (int dt = 0; dt < 4; ++dt) { const bf16* vp = Vt + (size_t)(dt * 16 + fr) * NKEY + key0 + fq * 4;
      us4 v0 = ldg4(vp), v1 = ldg4(vp + 16);
#pragma unroll
      for (int e = 0; e < 4; ++e) { vf[dt][e] = (short)v0[e]; vf[dt][4 + e] = (short)v1[e]; } }
#pragma unroll
    for (int qi = 0; qi < 2; ++qi) {
      f32x4 s[2];
#pragma unroll
      for (int kt = 0; kt < 2; ++kt) { s[kt] = (f32x4){0.f, 0.f, 0.f, 0.f};
#pragma unroll
        for (int kk = 0; kk < KS; ++kk) s[kt] = mfma16(kf[kt][kk], qf[qi][kk], s[kt]); }
      float mx = -1e30f;
#pragma unroll
      for (int kt = 0; kt < 2; ++kt)
#pragma unroll
        for (int r = 0; r < 4; ++r) { float v = s[kt][r] * scale;
          if (masked) { int kp = key0 + kt * 16 + fq * 4 + r; int dq = qpos0 + qi * 16 + fr - kp; if (dq > 128 || dq < -128) v = -1e30f; }
          s[kt][r] = v; mx = fmaxf(mx, v); }
      mx = fmaxf(mx, shx(mx, 16, lane)); mx = fmaxf(mx, shx(mx, 32, lane));
      const float mnew = fmaxf(mrun[qi], mx);
      const float alpha = exp2f((mrun[qi] - mnew) * L2E);
      mrun[qi] = mnew;
      bf16x8 pf; float ps = 0.f;
#pragma unroll
      for (int kt = 0; kt < 2; ++kt)
#pragma unroll
        for (int r = 0; r < 4; ++r) { float pv = exp2f((s[kt][r] - mnew) * L2E); ps += pv; pf[kt * 4 + r] = (short)f2bf(pv); }
      lrun[qi] = lrun[qi] * alpha + ps;
#pragma unroll
      for (int dt = 0; dt < 4; ++dt) { O[qi][dt] *= alpha; O[qi][dt] = mfma16(vf[dt], pf, O[qi][dt]); }
    }
  }
#pragma unroll
  for (int qi = 0; qi < 2; ++qi) {
    float l = lrun[qi]; l += shx(l, 16, lane); l += shx(l, 32, lane);
    const float inv = 1.f / l;
#pragma unroll
    for (int dt = 0; dt < 4; ++dt)
      stg4(out + (size_t)(qi * 16 + fr) * ldo + dt * 16 + fq * 4, pack4(O[qi][dt][0] * inv, O[qi][dt][1] * inv, O[qi][dt][2] * inv, O[qi][dt][3] * inv));
  }
}

DEV void mla_item(const Params& p, int i) {
  const int tidx_ = opaque_tid();
  const bf16* KMLA = reinterpret_cast<const bf16*>(p.ws + O_KMLA); const bf16* VTMLA = reinterpret_cast<const bf16*>(p.ws + O_VTMLA);
  const bf16* QMLA = reinterpret_cast<const bf16*>(p.ws + O_QMLA); bf16* YBR = reinterpret_cast<bf16*>(p.ws + O_H);
  const int wv = __builtin_amdgcn_readfirstlane(tidx_ >> 6);
  int b, h, t, lo, hi;
  if (i < 256) { b = i >> 5; h = (i >> 3) & 3; t = b * 2048 + (i & 7) * 256 + wv * 32; lo = 0; hi = 72; }
  else { int j = i - 256; b = j >> 2; h = j & 3; t = TL + b * 256 + wv * 32; lo = 64; hi = 72; }
  attn_wave<3>(QMLA + (size_t)t * 384 + h * 96, 384, KMLA + (size_t)(b * 4 + h) * NKEY * 96, VTMLA + (size_t)(b * 4 + h) * 64 * NKEY,
               lo, hi, 0, 0, false, 0, 0.10206207261596577f, false, 0.f, YBR + (size_t)t * 256 + h * 64, 256);
}
DEV void gqa_item(const Params& p, int l, int i) {
  const int tidx_ = opaque_tid();
  const bf16* GQ = reinterpret_cast<const bf16*>(p.ws + O_GQ); const bf16* GK = reinterpret_cast<const bf16*>(p.ws + O_GK);
  const bf16* GVT = reinterpret_cast<const bf16*>(p.ws + O_GVT); bf16* YBR1 = reinterpret_cast<bf16*>(p.ws + O_H) + (size_t)T * 256;
  const int wv = __builtin_amdgcn_readfirstlane(tidx_ >> 6);
  int b, hq, t, alo = 0, ahi = 0, qp = 0;
  if (i < 256) { b = i >> 5; hq = (i >> 3) & 3; qp = (i & 7) * 256 + wv * 32; t = b * 2048 + qp;
    alo = max(0, qp - 128) >> 5; ahi = (min(2047, qp + 159) >> 5) + 1; }
  else { int j = i - 256; b = j >> 2; hq = j & 3; t = TL + b * 256 + wv * 32; }
  const int kvh = hq >> 1;
  const float sink = p.in[15][l * 4 + hq];
  attn_wave<2>(GQ + (size_t)t * 256 + hq * 64, 256, GK + (size_t)(b * 2 + kvh) * NKEY * 64, GVT + (size_t)(b * 2 + kvh) * 64 * NKEY,
               alo, ahi, 64, 72, true, qp, 0.125f, true, sink, YBR1 + (size_t)t * 256 + hq * 64, 256);
}

DEV int s5_token(int b, int dir, int s) {
  if (s < 256) { int pos = dir ? 255 - s : s; return TL + b * 256 + pos; }
  int q = s - 256; int pos = dir ? 2047 - q : q; return b * 2048 + pos;
}
DEV void s5_item(const Params& p, int l, int item) {
  const int tidx_ = opaque_tid();
  extern __shared__ __attribute__((aligned(16))) unsigned char smem[];
  const int b = item >> 5, g = (item >> 1) & 15, dir = item & 1;
  const int lane = tidx_ & 63, wv = __builtin_amdgcn_readfirstlane(tidx_ >> 6), fr = lane & 15, fq = lane >> 4;
  float* Us = reinterpret_cast<float*>(smem + wv * 5376);
  unsigned short* Sst = reinterpret_cast<unsigned short*>(smem + wv * 5376 + 1024);
  float* Ex = reinterpret_cast<float*>(smem + 8 * 5376);
  const bf16* PROJ = reinterpret_cast<const bf16*>(p.ws + O_PROJ);
  float* S5Y = reinterpret_cast<float*>(p.ws + O_Y) + (size_t)dir * T * 256;
  const int gi = (l * 2 + dir) * 16 + g;
  float lre = fminf(p.in[16][gi * 64 + lane], -1e-4f), lim = p.in[17][gi * 64 + lane];
  const float dt = expf(p.in[18][gi]);
  const float mag = expf(lre * dt);
  float sn, cs; sincos_acc(lim * dt, sn, cs);
  const float a_re = mag * cs, a_im = mag * sn;
  const float nr = a_re - 1.f, ni = a_im, den = lre * lre + lim * lim;
  const float cre = (nr * lre + ni * lim) / den, cim = (ni * lre - nr * lim) / den;
  float bbr[16], bbi[16];
  {
    const float* br = p.in[19] + ((size_t)gi * 64 + lane) * 16; const float* bi = p.in[20] + ((size_t)gi * 64 + lane) * 16;
#pragma unroll
    for (int q4 = 0; q4 < 4; ++q4) { f32x4 r4 = *reinterpret_cast<const f32x4*>(br + q4 * 4), i4 = *reinterpret_cast<const f32x4*>(bi + q4 * 4);
#pragma unroll
      for (int e = 0; e < 4; ++e) { bbr[q4 * 4 + e] = cre * r4[e] - cim * i4[e]; bbi[q4 * 4 + e] = cre * i4[e] + cim * r4[e]; } }
  }
  bf16x8 cf[4];
#pragma unroll
  for (int kk = 0; kk < 4; ++kk) {
    const float* src = (kk < 2 ? p.in[21] : p.in[22]) + ((size_t)gi * 16 + fr) * 64 + (kk & 1) * 32 + fq * 8;
    const float sg = kk < 2 ? 1.f : -1.f;
#pragma unroll
    for (int e = 0; e < 8; ++e) cf[kk][e] = (short)f2bf(sg * src[e]);
  }
  const int sbase = wv * 288;
  float sre = 0.f, sim = 0.f;
#pragma unroll 1
  for (int pass = 0; pass < 2; ++pass) {
#pragma unroll 1
    for (int sc = 0; sc < 18; ++sc) {
      const int s0 = sbase + sc * 16;
      { const int tt = lane >> 2, h4 = (lane & 3) * 4; const int tok = s5_token(b, dir, s0 + tt);
        us4 raw = ldg4(PROJ + (size_t)tok * INP + C_U + g * 16 + h4);
        *reinterpret_cast<f32x4*>(Us + tt * 16 + h4) = (f32x4){bf2f(raw[0]), bf2f(raw[1]), bf2f(raw[2]), bf2f(raw[3])}; }
#pragma unroll
      for (int tt = 0; tt < 16; ++tt) {
        float bur = 0.f, bui = 0.f;
#pragma unroll
        for (int q4 = 0; q4 < 4; ++q4) { f32x4 u4 = *reinterpret_cast<const f32x4*>(Us + tt * 16 + q4 * 4);
#pragma unroll
          for (int e = 0; e < 4; ++e) { bur = fmaf(bbr[q4 * 4 + e], u4[e], bur); bui = fmaf(bbi[q4 * 4 + e], u4[e], bui); } }
        const float nre = a_re * sre - a_im * sim + bur, nim = a_re * sim + a_im * sre + bui;
        sre = nre; sim = nim;
        if (pass == 1) { Sst[tt * 136 + lane] = f2bf(sre); Sst[tt * 136 + 64 + lane] = f2bf(sim); }
      }
      if (pass == 1) {
        f32x4 acc = {0.f, 0.f, 0.f, 0.f};
#pragma unroll
        for (int kk = 0; kk < 4; ++kk) { bf16x8 sf = *reinterpret_cast<const bf16x8*>(Sst + fr * 136 + kk * 32 + fq * 8); acc = mfma16(cf[kk], sf, acc); }
        const int tok = s5_token(b, dir, s0 + fr);
        *reinterpret_cast<f32x4*>(S5Y + (size_t)tok * 256 + g * 16 + fq * 4) = acc;
      }
    }
    if (pass == 0) {
      Ex[wv * 128 + lane] = sre; Ex[wv * 128 + 64 + lane] = sim;
      __syncthreads();
      float pr = 1.f, pi = 0.f;
#pragma unroll 1
      for (int i = 0; i < 288; ++i) { float t1 = pr * a_re - pi * a_im, t2 = pr * a_im + pi * a_re; pr = t1; pi = t2; }
      float cr = 0.f, ci = 0.f;
      for (int w2 = 0; w2 < wv; ++w2) { float er = Ex[w2 * 128 + lane], ei = Ex[w2 * 128 + 64 + lane];
        float t1 = pr * cr - pi * ci + er, t2 = pr * ci + pi * cr + ei; cr = t1; ci = t2; }
      sre = cr; sim = ci;
    }
  }
}

DEV void gmlp_item(const Params& p, int l, int item) {
  const int tidx_ = opaque_tid();
  extern __shared__ __attribute__((aligned(16))) unsigned char smem[];
  unsigned short* vT = reinterpret_cast<unsigned short*>(smem);
  const bf16* PROJ = reinterpret_cast<const bf16*>(p.ws + O_PROJ);
  const bf16* WS = reinterpret_cast<const bf16*>(p.ws + O_WSP);
  bf16* YBR3 = reinterpret_cast<bf16*>(p.ws + O_H) + (size_t)3 * T * 256;
  const float* gn = p.in[26] + l * 256; const float* bs = p.in[28] + l * 512;
  const int lane = tidx_ & 63, wv = __builtin_amdgcn_readfirstlane(tidx_ >> 6), fr = lane & 15, fq = lane >> 4;
  const int t0 = item * 128;
  f32x4 g4 = *reinterpret_cast<const f32x4*>(gn + lane * 4);
  for (int i = 0; i < 16; ++i) {
    const int tk = wv * 16 + i;
    us4 raw = ldg4(PROJ + (size_t)(t0 + tk) * INP + C_Z + 256 + lane * 4);
    float v[4]; float s = 0.f;
#pragma unroll
    for (int e = 0; e < 4; ++e) { v[e] = geluf_(bf2f(raw[e])); s += v[e]; }
    const float mean = wave_sum(s, lane) * (1.f / 256.f);
    float q = 0.f;
#pragma unroll
    for (int e = 0; e < 4; ++e) { v[e] -= mean; q += v[e] * v[e]; }
    const float rstd = rsqrtf(wave_sum(q, lane) * (1.f / 256.f) + 1e-5f);
#pragma unroll
    for (int e = 0; e < 4; ++e) vT[(lane * 4 + e) * 136 + tk] = f2bf(v[e] * rstd * g4[e]);
  }
  __syncthreads();
  const int i0 = wv * 16; const int tok = t0 + i0 + fr;
  for (int ct = 0; ct < 16; ++ct) {
    const int g = ct >> 2;
    f32x4 acc = {0.f, 0.f, 0.f, 0.f};
#pragma unroll
    for (int kk = 0; kk < 4; ++kk) {
      bf16x8 af = *reinterpret_cast<const bf16x8*>(vT + (ct * 16 + fr) * 136 + kk * 32 + fq * 8);
      bf16x8 wf = ldg8(WS + (size_t)(g * 128 + i0 + fr) * 128 + kk * 32 + fq * 8);
      acc = mfma16(af, wf, acc);
    }
    const float bias = bs[g * 128 + i0 + fr];
    us4 ur = ldg4(PROJ + (size_t)tok * INP + C_Z + ct * 16 + fq * 4);
    stg4(YBR3 + (size_t)tok * 256 + ct * 16 + fq * 4,
         pack4(geluf_(bf2f(ur[0])) * (acc[0] + bias), geluf_(bf2f(ur[1])) * (acc[1] + bias), geluf_(bf2f(ur[2])) * (acc[2] + bias), geluf_(bf2f(ur[3])) * (acc[3] + bias)));
  }
}

DEV void m2_phase(const Params& p, int l) {
  const bool last = (l == 3);
  for (int item = blockIdx.x; item < 976; item += gridDim.x) {
    if (item < 256) s5_item(p, l, item);
    else if (item < 544) { int i = item - 256; if (!(last && i >= 256)) mla_item(p, i); }
    else if (item < 832) { int i = item - 544; if (!(last && i >= 256)) gqa_item(p, l, i); }
    else { int i = item - 832; if (!(last && i >= 128)) gmlp_item(p, l, i); }
    __syncthreads();
  }
}

DEV void m3_phase(const Params& p, int l) {
  const int tidx_ = opaque_tid();
  const bf16* PROJ = reinterpret_cast<const bf16*>(p.ws + O_PROJ);
  const float* Y0 = reinterpret_cast<const float*>(p.ws + O_Y); const float* Y1 = Y0 + (size_t)T * 256;
  const bf16* WGLU = reinterpret_cast<const bf16*>(p.ws + O_WGLU);
  bf16* YBR2 = reinterpret_cast<bf16*>(p.ws + O_H) + (size_t)2 * T * 256;
  const float* dsk = p.in[23] + l * 256; const float* bg = p.in[25] + l * 512;
  const int lane = tidx_ & 63, wv = __builtin_amdgcn_readfirstlane(tidx_ >> 6), fr = lane & 15, fq = lane >> 4;
  const int ntile = (l == 3) ? TL / 16 : T / 16;
  for (int tile = blockIdx.x * 8 + wv; tile < ntile; tile += gridDim.x * 8) {
    const int tok = tile * 16 + fr;
    bf16x8 af[8];
#pragma unroll
    for (int kk = 0; kk < 8; ++kk) {
      const int ch0 = kk * 32 + fq * 8;
      bf16x8 ur = ldg8(PROJ + (size_t)tok * INP + C_U + ch0);
#pragma unroll
      for (int hh = 0; hh < 2; ++hh) {
        f32x4 y0 = *reinterpret_cast<const f32x4*>(Y0 + (size_t)tok * 256 + ch0 + hh * 4);
        f32x4 y1 = *reinterpret_cast<const f32x4*>(Y1 + (size_t)tok * 256 + ch0 + hh * 4);
        f32x4 d4 = *reinterpret_cast<const f32x4*>(dsk + ch0 + hh * 4);
#pragma unroll
        for (int e = 0; e < 4; ++e) af[kk][hh * 4 + e] = (short)f2bf(geluf_(y0[e] + y1[e] + d4[e] * bfs2f(ur[hh * 4 + e])));
      }
    }
    for (int nt = 0; nt < 16; ++nt) {
      f32x4 aa = {0.f, 0.f, 0.f, 0.f}, ag = {0.f, 0.f, 0.f, 0.f};
#pragma unroll
      for (int kk = 0; kk < 8; ++kk) {
        aa = mfma16(ldg8(WGLU + (size_t)(nt * 16 + fr) * 256 + kk * 32 + fq * 8), af[kk], aa);
        ag = mfma16(ldg8(WGLU + (size_t)(256 + nt * 16 + fr) * 256 + kk * 32 + fq * 8), af[kk], ag);
      }
      const int n = nt * 16 + fq * 4;
      f32x4 ba = *reinterpret_cast<const f32x4*>(bg + n), bgg = *reinterpret_cast<const f32x4*>(bg + 256 + n);
      float o[4];
#pragma unroll
      for (int r = 0; r < 4; ++r) o[r] = (aa[r] + ba[r]) * sigmoidf_(ag[r] + bgg[r]);
      stg4(YBR2 + (size_t)tok * 256 + n, pack4(o[0], o[1], o[2], o[3]));
    }
  }
}

constexpr int NPHASE = 2 + 13 * 4;

DEV void run_phase(const Params& p, int ph) {
  unsigned char* ws = p.ws;
  bf16* H = reinterpret_cast<bf16*>(ws + O_H);
  bf16* PROJ = reinterpret_cast<bf16*>(ws + O_PROJ);
  float* Y = reinterpret_cast<float*>(ws + O_Y);
  bf16* MRG = reinterpret_cast<bf16*>(ws + O_MRG);
  if (ph == 0) { if (EMASK & 0x2000) { mod_phase(p); __syncthreads(); conv_phase(p, 0); } return; }
  if (ph == 1) { if (EMASK & 0x4000) e_phase(p, 0, 0); return; }
  const int l = (ph - 2) / 13, k = (ph - 2) % 13;
  const bool last = (l == 3);
  if (!((EMASK >> k) & 1)) return;
  switch (k) {
    case 0: case 10: {
      const int j = (k == 0) ? 0 : 1;
      const int M = (last && j == 1) ? TL : T;
      gemm_phase(H, 1024, reinterpret_cast<const bf16*>(ws + O_WFI) + (size_t)j * 5632 * 1024, 1024, M, 5632, 1024, EpiSwiglu{PROJ});
    } break;
    case 1: case 11: {
      const int j = (k == 1) ? 0 : 1;
      const int M = (last && j == 1) ? TL : T;
      gemm_phase(PROJ, 2816, reinterpret_cast<const bf16*>(ws + O_WFO) + (size_t)j * 1024 * 2816, 2816, M, 1024, 2816, EpiF32{Y});
    } break;
    case 2: e_phase(p, l, 1); break;
    case 3: gemm_phase(H, 1024, reinterpret_cast<const bf16*>(ws + O_WIN), 1024, T, INP, 1024, EpiBf16{PROJ}); break;
    case 4: m1_phase(p, l); break;
    case 5: m2_phase(p, l); break;
    case 6: m3_phase(p, l); break;
    case 7: {
      const int M = last ? TL : T;
      const int nM = M / 256, nN = 4, ntile = nM * nN;
      for (int t = vblock(); t < ntile; t += gridDim.x) {
        int pm, pn; tile_of(t, nM, nN, pm, pn);
        const bf16* WBR = reinterpret_cast<const bf16*>(ws + O_WBR);
        { EpiBranch<0> e{PROJ, Y, MRG}; gemm_tile(H, 256, WBR, 256, 256, pm * 256, pn * 256, e); }
        { EpiBranch<1> e{PROJ, Y, MRG}; gemm_tile(H + (size_t)1 * T * 256, 256, WBR + (size_t)1 * 1024 * 256, 256, 256, pm * 256, pn * 256, e); }
        { EpiBranch<2> e{PROJ, Y, MRG}; gemm_tile(H + (size_t)2 * T * 256, 256, WBR + (size_t)2 * 1024 * 256, 256, 256, pm * 256, pn * 256, e); }
        { EpiBranch<3> e{PROJ, Y, MRG}; gemm_tile(H + (size_t)3 * T * 256, 256, WBR + (size_t)3 * 1024 * 256, 256, 256, pm * 256, pn * 256, e); }
      }
    } break;
    case 8: gemm_phase(MRG, 1024, reinterpret_cast<const bf16*>(ws + O_WOUT), 1024, last ? TL : T, 1024, 1024, EpiF32{Y}); break;
    case 9: e_phase(p, l, 2); break;
    case 12: e_phase(p, l, 3); if (!last) { __syncthreads(); conv_phase(p, l + 1); } break;
  }
}

__global__ void __launch_bounds__(512, 2) fwd_kernel(Params p) {
  for (int ph = p.lo; ph < p.hi; ++ph) {
    run_phase(p, ph);
    if (ph + 1 < p.hi) cg::this_grid().sync();
  }
}

extern "C" void kernel_launch(void* const* d_in, const int* in_sizes, int n_in, void* d_out, int out_size, void* d_ws, size_t ws_size, hipStream_t stream) {
  static int grid = 0;
  if (grid == 0) {
    if (n_in != 31 || ws_size < O_END) { fprintf(stderr, "kernel_launch: unexpected inputs (n_in %d, ws %zu < %zu)\n", n_in, ws_size, (size_t)O_END); grid = -1; return; }
    if (hipFuncSetAttribute((const void*)fwd_kernel, hipFuncAttributeMaxDynamicSharedMemorySize, LDS_BYTES) != hipSuccess) { fprintf(stderr, "hipFuncSetAttribute failed\n"); grid = -1; return; }
    int dev = 0, cus = 0, per_cu = 0;
    hipGetDevice(&dev);
    hipDeviceGetAttribute(&cus, hipDeviceAttributeMultiprocessorCount, dev);
    hipOccupancyMaxActiveBlocksPerMultiprocessor(&per_cu, (const void*)fwd_kernel, 512, LDS_BYTES);
    if (per_cu < 1) { fprintf(stderr, "occupancy query returned %d\n", per_cu); per_cu = 1; }
    grid = cus * 1;
    (void)hipGetLastError();
  }
  if (grid < 0) return;
  Params p{};
  for (int i = 0; i < 31; ++i) p.in[i] = (const float*)d_in[i];
  p.out = (float*)d_out; p.ws = (unsigned char*)d_ws;
#if COOP
  p.lo = 0; p.hi = NPHASE;
  void* args[] = {&p};
  hipError_t e = hipLaunchCooperativeKernel((const void*)fwd_kernel, dim3(grid), dim3(512), args, LDS_BYTES, stream);
  if (e != hipSuccess) fprintf(stderr, "cooperative launch failed: %s (grid %d)\n", hipGetErrorString(e), grid);
#else
  for (int ph = 0; ph < NPHASE; ++ph) {
    p.lo = ph; p.hi = ph + 1;
    hipLaunchKernelGGL(fwd_kernel, dim3(grid), dim3(512), LDS_BYTES, stream, p);
  }
#endif
}
```

```cpp
#include <hip/hip_runtime.h>
#include <hip/hip_bf16.h>
#include <hip/hip_cooperative_groups.h>
#include <cstdio>
namespace cg = cooperative_groups;

#ifndef EMASK
#define EMASK 0x7fff
#endif
#ifndef DBLMASK
#define DBLMASK 0
#endif
#ifndef XSYNC
#define XSYNC 0
#endif
#ifndef COOP
#define COOP 1
#endif

using bf16 = __hip_bfloat16;
typedef short bf16x8 __attribute__((ext_vector_type(8)));
typedef float f32x4 __attribute__((ext_vector_type(4)));
typedef unsigned short us4 __attribute__((ext_vector_type(4)));
#define DEV __device__ __forceinline__

constexpr int T = 18432, TL = 16384, INP = 5888, NKEY = 2304;
constexpr int C_KVL = 0, C_KPE = 128, C_GK = 160, C_GV = 288, C_U = 416, C_QL = 672, C_GQ = 928, C_Z = 1184, C_GATE = 1696;
constexpr int LDS_BYTES = 131072 + 64;

constexpr size_t O_WFI = 0;
constexpr size_t O_WFO = O_WFI + 23068672;
constexpr size_t O_WIN = O_WFO + 11534336;
constexpr size_t O_WBR = O_WIN + 12058624;
constexpr size_t O_WOUT = O_WBR + 2097152;
constexpr size_t O_WUQ = O_WOUT + 2097152;
constexpr size_t O_WUKV = O_WUQ + 196608;
constexpr size_t O_WGLU = O_WUKV + 131072;
constexpr size_t O_WSP = O_WGLU + 262144;
constexpr size_t WSZ = O_WSP + 131072;
constexpr size_t O_MOD = 2 * WSZ;
constexpr size_t O_X = O_MOD + 1327104;
constexpr size_t O_H = O_X + 75497472;
constexpr size_t O_PROJ = O_H + 37748736;
constexpr size_t O_Y = O_PROJ + 217055232;
constexpr size_t O_MRG = O_Y + 75497472;
constexpr size_t O_GQ = O_MRG + 37748736;
constexpr size_t O_GK = O_GQ + 9437184;
constexpr size_t O_GVT = O_GK + 4718592;
constexpr size_t O_BAR = O_GVT + 4718592;
constexpr size_t O_H2 = O_BAR + 16384;
constexpr size_t O_END = O_H2 + 37748736;
constexpr size_t O_KMLA = O_MRG, O_VTMLA = O_MRG + 14155776, O_QMLA = O_VTMLA + 9437184;

struct Params {
  const float* in[31];
  float* out;
  unsigned char* ws;
  int lo, hi;
};

typedef __bf16 bf2_t __attribute__((ext_vector_type(2)));
typedef float f2_t __attribute__((ext_vector_type(2)));
typedef unsigned u32x2 __attribute__((ext_vector_type(2)));
typedef unsigned u32x4 __attribute__((ext_vector_type(4)));
DEV unsigned pk2(float a, float b) { f2_t v = {a, b}; bf2_t r = __builtin_convertvector(v, bf2_t); return *reinterpret_cast<unsigned*>(&r); }
DEV unsigned short f2bf(float f) { return (unsigned short)(pk2(f, 0.f) & 0xffffu); }
DEV bf16x8 pack8(float a0, float a1, float a2, float a3, float a4, float a5, float a6, float a7) {
  u32x4 r = {pk2(a0, a1), pk2(a2, a3), pk2(a4, a5), pk2(a6, a7)}; return *reinterpret_cast<bf16x8*>(&r); }
DEV float bf2f(unsigned short h) { return __uint_as_float(((unsigned)h) << 16); }
DEV float bfs2f(short h) { return __uint_as_float(((unsigned)(unsigned short)h) << 16); }
DEV u32x2 pack4(float a, float b, float c, float d) { u32x2 r = {pk2(a, b), pk2(c, d)}; return r; }
DEV bf16x8 ldg8(const bf16* p) { return *reinterpret_cast<const bf16x8*>(p); }
DEV us4 ldg4(const bf16* p) { return *reinterpret_cast<const us4*>(p); }
DEV void stg4(bf16* p, u32x2 v) { *reinterpret_cast<u32x2*>(p) = v; }
DEV float shx(float v, int mask, int lane) { return __int_as_float(__builtin_amdgcn_ds_bpermute((lane ^ mask) << 2, __float_as_int(v))); }
DEV float max_x16_x32(float v) {
  unsigned u = __float_as_uint(v);
  auto r = __builtin_amdgcn_permlane32_swap(u, u, false, false);
  float m = fmaxf(__uint_as_float(r[0]), __uint_as_float(r[1]));
  u = __float_as_uint(m);
  auto r2 = __builtin_amdgcn_permlane16_swap(u, u, false, false);
  return fmaxf(__uint_as_float(r2[0]), __uint_as_float(r2[1]));
}
DEV float sum_x16_x32(float v) {
  unsigned u = __float_as_uint(v);
  auto r = __builtin_amdgcn_permlane32_swap(u, u, false, false);
  float m = __uint_as_float(r[0]) + __uint_as_float(r[1]);
  u = __float_as_uint(m);
  auto r2 = __builtin_amdgcn_permlane16_swap(u, u, false, false);
  return __uint_as_float(r2[0]) + __uint_as_float(r2[1]);
}
DEV float dpp_(float v, int ctrl_b1, int which) {
  (void)ctrl_b1;
  const int x = __float_as_int(v);
  int r;
  if (which == 0) r = __builtin_amdgcn_update_dpp(x, x, 0xB1, 0xF, 0xF, false);
  else if (which == 1) r = __builtin_amdgcn_update_dpp(x, x, 0x4E, 0xF, 0xF, false);
  else if (which == 2) r = __builtin_amdgcn_update_dpp(x, x, 0x141, 0xF, 0xF, false);
  else r = __builtin_amdgcn_update_dpp(x, x, 0x140, 0xF, 0xF, false);
  return __int_as_float(r);
}
DEV float sum8_(float v) { v += dpp_(v, 0, 0); v += dpp_(v, 0, 1); v += dpp_(v, 0, 2); return v; }
DEV float wave_sum(float v, int lane) {
  (void)lane;
  v = sum8_(v); v += dpp_(v, 0, 3);
  return sum_x16_x32(v); }
DEV float rcp_(float x) { return __builtin_amdgcn_rcpf(x); }
DEV float sigmoidf_(float x) { return rcp_(1.f + __expf(-x)); }
DEV float siluf_(float x) { return x * rcp_(1.f + __expf(-x)); }
DEV float geluf_(float x) { float u = 0.7978845608028654f * (x + 0.044715f * x * x * x); float e = __expf(2.f * u); return x * (1.f - rcp_(1.f + e)); }
DEV int opaque_tid() { int t; asm volatile("v_mov_b32 %0, %1" : "=v"(t) : "v"((int)threadIdx.x)); return t; }
DEV f32x4 mfma16(bf16x8 a, bf16x8 b, f32x4 c) { return __builtin_amdgcn_mfma_f32_16x16x32_bf16(a, b, c, 0, 0, 0); }

DEV void sincos_acc(float x, float& s, float& c) {
  float kf = rintf(x * 0.636619772367581f);
  int k = (int)kf;
  float r = fmaf(-kf, 1.5703125f, x);
  r = fmaf(-kf, 4.837512969970703125e-4f, r);
  r = fmaf(-kf, 7.54978995489188216e-8f, r);
  float r2 = r * r;
  float sp = r + r * r2 * (-1.6666667163e-01f + r2 * (8.3333337680e-03f + r2 * (-1.9841270114e-04f + r2 * 2.7557314297e-06f)));
  float cp = 1.0f + r2 * (-0.5f + r2 * (4.1666667908e-02f + r2 * (-1.3888889225e-03f + r2 * 2.4801587642e-05f)));
  int q = k & 3;
  s = (q == 0) ? sp : (q == 1) ? cp : (q == 2) ? -sp : -cp;
  c = (q == 0) ? cp : (q == 1) ? -sp : (q == 2) ? -cp : sp;
}
DEV float rope1(float x, float xp, bool is_x2, float pos, int fi, float nf) {
  float freq = __builtin_amdgcn_exp2f(-13.287712379549449f * (float)fi / nf);
  float s, c; sincos_acc(pos * freq, s, c);
  return is_x2 ? x * c + xp * s : x * c - xp * s;
}

DEV int lds_byte(int r, int c) {
  int st = (r >> 4) * 2 + (c >> 5), rr = r & 15, cc = c & 31, ob = rr * 64 + cc * 2;
  return st * 1024 + (ob ^ (((ob >> 9) & 1) << 5));
}
DEV void stage_rc(int b, int& R, int& C) {
  int st = b / 1024, sb = b % 1024, swz = sb ^ (((sb >> 9) & 1) << 5);
  R = (st >> 1) * 16 + swz / 64; C = (st & 1) * 32 + (swz % 64) / 2;
}

template <class Epi, int NB>
DEV void gemm_tile_nb(const bf16* __restrict__ A, int lda, long strideA, const bf16* __restrict__ Bt, int ldb, long strideB, int K, int brow, int bcol, Epi& epi) {
  const int tidx_ = opaque_tid();
  extern __shared__ __attribute__((aligned(16))) unsigned char smem[];
  bf16* shm = reinterpret_cast<bf16*>(smem);
  constexpr int BK = 64, HALF = 128, HT = HALF * BK;
#define SA(b, h) (shm + ((b) * 2 + (h)) * HT)
#define SB(b, h) (shm + (4 + (b) * 2 + (h)) * HT)
#define STAGE(P, BASE, LD, br, kt) do { const bf16* _gb = BASE + ((long)(br) * (LD) + (long)(kt) * BK); \
    _Pragma("unroll") for (int _i = 0; _i < 2; ++_i) { \
      __builtin_amdgcn_global_load_lds((const unsigned*)(_gb + ((&LD == &lda) ? offA[_i] : offB[_i])), \
        (unsigned*)((char*)(P) + tidx_ * 16 + _i * 8192), 16, 0, 0); } } while (0)
#define LDA(dst, b, h) _Pragma("unroll") for (int m = 0; m < 4; ++m) _Pragma("unroll") for (int k = 0; k < 2; ++k) \
    dst[m][k] = *reinterpret_cast<const bf16x8*>(smem + (((b) * 2 + (h)) * 16384 + m * 2048 + k * 1024) + aoff)
#define LDB(dst, b, h) _Pragma("unroll") for (int n = 0; n < 2; ++n) _Pragma("unroll") for (int k = 0; k < 2; ++k) \
    dst[n][k] = *reinterpret_cast<const bf16x8*>(smem + (((b) * 2 + (h)) * 16384 + n * 2048 + k * 1024) + boff)
#define MMA(ai, bj, At_, Bt_) do { __builtin_amdgcn_s_setprio(1); \
    _Pragma("unroll") for (int m = 0; m < 4; ++m) _Pragma("unroll") for (int n = 0; n < 2; ++n) _Pragma("unroll") for (int k = 0; k < 2; ++k) \
      acc[ai][bj][m][n] = __builtin_amdgcn_mfma_f32_16x16x32_bf16(Bt_[n][k], At_[m][k], acc[ai][bj][m][n], 0, 0, 0); \
    __builtin_amdgcn_s_setprio(0); } while (0)
#define WAIT_V(n) asm volatile("s_waitcnt vmcnt(" #n ")" ::: "memory")
#define WAIT_L(n) asm volatile("s_waitcnt lgkmcnt(" #n ")" ::: "memory")
#define BAR __builtin_amdgcn_s_barrier()
#define SCHED __builtin_amdgcn_sched_barrier(0)
  const int wid = __builtin_amdgcn_readfirstlane(tidx_ >> 6), lane = tidx_ & 63, wr = wid >> 2, wc = wid & 3, fr = lane & 15, fq = lane >> 4;
  f32x4 acc[2][2][4][2] = {};
  bf16x8 At[4][2], B0[2][2], B1[2][2];
  const int nt = K / BK;
  const int lane_off_ = (fr * 64 + fq * 16) ^ ((fr >> 3) << 5);
  const int aoff = wr * 8192 + lane_off_, boff = 65536 + wc * 4096 + lane_off_;
  unsigned offA[2], offB[2];
#pragma unroll
  for (int _i = 0; _i < 2; ++_i) { int _r, _c; stage_rc(tidx_ * 16 + _i * 8192, _r, _c); offA[_i] = (unsigned)(_r * lda + _c); offB[_i] = (unsigned)(_r * ldb + _c); }
#pragma unroll 1
  for (int br = 0; br < NB; ++br) {
  STAGE(SB(0, 0), Bt, ldb, bcol, 0); STAGE(SA(0, 0), A, lda, brow, 0);
  STAGE(SB(0, 1), Bt, ldb, bcol + HALF, 0); STAGE(SA(0, 1), A, lda, brow + HALF, 0);
  if (wr == 1) BAR;
  WAIT_V(4); BAR;
  STAGE(SB(1, 0), Bt, ldb, bcol, 1); STAGE(SA(1, 0), A, lda, brow, 1); STAGE(SB(1, 1), Bt, ldb, bcol + HALF, 1);
  WAIT_V(6); BAR;
  for (int t = 0; t < nt - 2; t += 2) {
    LDB(B0, 0, 0); SCHED; LDA(At, 0, 0); STAGE(SA(1, 1), A, lda, brow + HALF, t + 1);
    WAIT_L(8); BAR; WAIT_L(0); MMA(0, 0, At, B0); BAR; SCHED;
    LDB(B1, 0, 1); STAGE(SB(0, 0), Bt, ldb, bcol, t + 2);
    BAR; WAIT_L(0); MMA(0, 1, At, B1); BAR;
    LDA(At, 0, 1); STAGE(SA(0, 0), A, lda, brow, t + 2);
    BAR; WAIT_L(0); MMA(1, 0, At, B0); BAR; SCHED;
    STAGE(SB(0, 1), Bt, ldb, bcol + HALF, t + 2);
    WAIT_V(6); BAR; MMA(1, 1, At, B1); BAR;
    LDB(B0, 1, 0); SCHED; LDA(At, 1, 0); STAGE(SA(0, 1), A, lda, brow + HALF, t + 2);
    WAIT_L(8); BAR; WAIT_L(0); MMA(0, 0, At, B0); BAR; SCHED;
    LDB(B1, 1, 1); STAGE(SB(1, 0), Bt, ldb, bcol, t + 3);
    BAR; WAIT_L(0); MMA(0, 1, At, B1); BAR;
    LDA(At, 1, 1); STAGE(SA(1, 0), A, lda, brow, t + 3);
    BAR; WAIT_L(0); MMA(1, 0, At, B0); BAR; SCHED;
    STAGE(SB(1, 1), Bt, ldb, bcol + HALF, t + 3);
    WAIT_V(6); BAR; MMA(1, 1, At, B1); BAR;
  }
  { LDB(B0, 0, 0); LDA(At, 0, 0); STAGE(SA(1, 1), A, lda, brow + HALF, nt - 1);
    BAR; WAIT_L(0); MMA(0, 0, At, B0); BAR;
    LDB(B1, 0, 1); BAR; WAIT_L(0); MMA(0, 1, At, B1); BAR;
    LDA(At, 0, 1); WAIT_V(4); BAR; WAIT_L(0); MMA(1, 0, At, B0); MMA(1, 1, At, B1); BAR; }
  { LDB(B0, 1, 0); LDA(At, 1, 0); WAIT_V(2); BAR; WAIT_L(0); MMA(0, 0, At, B0); BAR;
    LDB(B1, 1, 1); WAIT_V(0); BAR; WAIT_L(0); MMA(0, 1, At, B1); BAR;
    LDA(At, 1, 1); BAR; WAIT_L(0); MMA(1, 0, At, B0); MMA(1, 1, At, B1); BAR; }
  if (wr == 0) BAR;
  if constexpr (NB > 1) {
    if (br + 1 < NB) {
#pragma unroll
      for (int ai = 0; ai < 2; ++ai)
#pragma unroll
        for (int bj = 0; bj < 2; ++bj)
          { epi.mid(brow + ai * HALF + wr * 64 + fr, bcol + bj * HALF + wc * 32, fq, acc[ai][bj], br); __builtin_amdgcn_sched_barrier(0); }
    }
    A += strideA; Bt += strideB;
  }
  }
  if constexpr (Epi::PAIR) {
#pragma unroll
    for (int ai = 0; ai < 2; ++ai)
      { epi.pair(brow + ai * HALF + wr * 64 + fr, (bcol >> 1) + wc * 32, fq, acc[ai][0], acc[ai][1]); __builtin_amdgcn_sched_barrier(0); }
  } else {
#pragma unroll
  for (int ai = 0; ai < 2; ++ai)
#pragma unroll
    for (int bj = 0; bj < 2; ++bj)
      { epi.quad(brow + ai * HALF + wr * 64 + fr, bcol + bj * HALF + wc * 32, fq, acc[ai][bj]); __builtin_amdgcn_sched_barrier(0); }
  }
#undef SA
#undef SB
#undef STAGE
#undef LDA
#undef LDB
#undef MMA
}

template <class Epi>
DEV void gemm_tile(const bf16* __restrict__ A, int lda, const bf16* __restrict__ Bt, int ldb, int K, int brow, int bcol, Epi& epi) {
  gemm_tile_nb<Epi, 1>(A, lda, 0, Bt, ldb, 0, K, brow, bcol, epi);
}

DEV int vblock() { const int G = gridDim.x, bx = blockIdx.x; return (G % 8 == 0) ? (bx % 8) * (G / 8) + bx / 8 : bx; }

DEV void tile_of(int t, int nM, int nN, int& pm, int& pn) {
  int nig = 8 * nN, gid = t / nig, fm = gid * 8, gsz = min(nM - fm, 8);
  pm = fm + (t % nig) % gsz; pn = (t % nig) / gsz;
}

template <class Epi>
DEV void gemm_phase(const bf16* A, int lda, const bf16* Bt, int ldb, int M, int N, int K, Epi epi) {
  const int nM = M / 256, nN = N / 256, ntile = nM * nN;
  for (int t = vblock(); t < ntile; t += gridDim.x) {
    int pm, pn; tile_of(t, nM, nN, pm, pn);
    gemm_tile(A, lda, Bt, ldb, K, pm * 256, pn * 256, epi);
  }
}

struct EpiSwiglu {
  bf16* h1;
  static constexpr bool PAIR = true;
  DEV void pair(int row0, int hcol, int fq, f32x4 (&a)[4][2], f32x4 (&g)[4][2]) const {
#pragma unroll
    for (int m = 0; m < 4; ++m) {
      float v[8];
#pragma unroll
      for (int n = 0; n < 2; ++n)
#pragma unroll
        for (int r = 0; r < 4; ++r) v[n * 4 + r] = siluf_(a[m][n][r]) * g[m][n][r];
      *reinterpret_cast<bf16x8*>(h1 + (size_t)(row0 + m * 16) * 2816 + hcol + fq * 8) = pack8(v[0], v[1], v[2], v[3], v[4], v[5], v[6], v[7]);
      __builtin_amdgcn_sched_barrier(0);
    }
  }
  DEV void quad(int, int, int, f32x4 (&)[4][2]) const {}
};
struct EpiF32 {
  static constexpr bool PAIR = false;
  bf16* out; static constexpr int ld = 1024;
  DEV void operator()(int row, int colbase, int fq, f32x4 a0, f32x4 a1) const {
    bf16* p = out + (size_t)row * ld + colbase + fq * 8;
    *reinterpret_cast<bf16x8*>(p) = pack8(a0[0], a0[1], a0[2], a0[3], a1[0], a1[1], a1[2], a1[3]);
  }
  DEV void quad(int row0, int colbase, int fq, f32x4 (&a)[4][2]) const {
#pragma unroll
    for (int m = 0; m < 4; ++m) { (*this)(row0 + m * 16, colbase, fq, a[m][0], a[m][1]); __builtin_amdgcn_sched_barrier(0); }
  }
};
struct EpiF32c {
  static constexpr bool PAIR = false;
  float* out;
  DEV void operator()(int row, int colbase, int fq, f32x4 a0, f32x4 a1) const {
    float* p = out + (size_t)(row - TL) * 1024 + colbase + fq * 8;
    *reinterpret_cast<f32x4*>(p) = a0; *reinterpret_cast<f32x4*>(p + 4) = a1;
  }
  DEV void quad(int row0, int colbase, int fq, f32x4 (&a)[4][2]) const {
#pragma unroll
    for (int m = 0; m < 4; ++m) { (*this)(row0 + m * 16, colbase, fq, a[m][0], a[m][1]); __builtin_amdgcn_sched_barrier(0); }
  }
};
struct EpiBf16 {
  static constexpr bool PAIR = false;
  bf16* out; static constexpr int ld = INP;
  DEV void operator()(int row, int colbase, int fq, f32x4 a0, f32x4 a1) const {
    bf16* p = out + (size_t)row * ld + colbase + fq * 8;
    *reinterpret_cast<bf16x8*>(p) = pack8(a0[0], a0[1], a0[2], a0[3], a1[0], a1[1], a1[2], a1[3]);
  }
  DEV void quad(int row0, int colbase, int fq, f32x4 (&a)[4][2]) const {
#pragma unroll
    for (int m = 0; m < 4; ++m) { (*this)(row0 + m * 16, colbase, fq, a[m][0], a[m][1]); __builtin_amdgcn_sched_barrier(0); }
  }
};
struct EpiBranch {
  static constexpr bool PAIR = false;
  const bf16* proj; bf16* merged;
  DEV void mid(int row0, int colbase, int fq, f32x4 (&a)[4][2], int br) const {
    asm volatile("" : "+v"(row0), "+v"(fq));
    bf16x8 ga[4], gb[4];
    const bf16* gp = proj + C_GATE + br * 1024 + colbase + fq * 8;
#pragma unroll
    for (int m = 0; m < 4; ++m) { const size_t row = row0 + m * 16; ga[m] = ldg8(gp + row * INP); gb[m] = ldg8(gp + row * INP + 1024); }
#pragma unroll
    for (int m = 0; m < 4; ++m)
#pragma unroll
      for (int n = 0; n < 2; ++n)
#pragma unroll
        for (int r = 0; r < 4; ++r) a[m][n][r] *= (1.f + __expf(-bfs2f(gb[m][n * 4 + r]))) * rcp_(1.f + __expf(-bfs2f(ga[m][n * 4 + r])));
  }
  DEV void quad(int row0, int colbase, int fq, f32x4 (&a)[4][2]) const {
    asm volatile("" : "+v"(row0), "+v"(fq));
    bf16x8 ga[4];
    const bf16* gp = proj + C_GATE + 3 * 1024 + colbase + fq * 8;
#pragma unroll
    for (int m = 0; m < 4; ++m) ga[m] = ldg8(gp + (size_t)(row0 + m * 16) * INP);
#pragma unroll
    for (int m = 0; m < 4; ++m) {
      float v[8];
#pragma unroll
      for (int n = 0; n < 2; ++n)
#pragma unroll
        for (int r = 0; r < 4; ++r) v[n * 4 + r] = a[m][n][r] * rcp_(1.f + __expf(-bfs2f(ga[m][n * 4 + r])));
      *reinterpret_cast<bf16x8*>(merged + (size_t)(row0 + m * 16) * 1024 + colbase + fq * 8) = pack8(v[0], v[1], v[2], v[3], v[4], v[5], v[6], v[7]);
    }
  }
};

DEV void mod_phase(const Params& p) {
  const int tidx_ = opaque_tid();
  extern __shared__ __attribute__((aligned(16))) unsigned char smem[];
  float* sl = reinterpret_cast<float*>(smem);
  float* part = sl + 9 * 1024;
  const int tid = tidx_;
  const float* c = p.in[1]; const float* cc = p.in[3]; const float* w_ada = p.in[4]; const float* b_ada = p.in[5];
  float* MOD = reinterpret_cast<float*>(p.ws + O_MOD);
  for (int i = tid; i < 9 * 1024; i += 512) { int r = i >> 10, k = i & 1023; float v = r < 8 ? c[r * 1024 + k] : cc[k]; sl[i] = v / (1.f + __expf(-v)); }
  __syncthreads();
  for (int item = blockIdx.x; item < 576; item += gridDim.x) {
    const int l = item / 144, n0 = (item % 144) * 64;
    const int cq = tid & 15, kg = tid >> 4;
    const float* w = w_ada + (size_t)l * 1024 * 9216 + n0 + cq * 4;
    float acc[9][4];
#pragma unroll
    for (int r = 0; r < 9; ++r) for (int e = 0; e < 4; ++e) acc[r][e] = 0.f;
#pragma unroll 4
    for (int kk = 0; kk < 32; ++kk) {
      const int k = kg * 32 + kk;
      f32x4 wv = *reinterpret_cast<const f32x4*>(w + (size_t)k * 9216);
#pragma unroll
      for (int r = 0; r < 9; ++r) { float s = sl[r * 1024 + k];
#pragma unroll
        for (int e = 0; e < 4; ++e) acc[r][e] = fmaf(s, wv[e], acc[r][e]); }
    }
#pragma unroll
    for (int r = 0; r < 9; ++r)
#pragma unroll
      for (int e = 0; e < 4; ++e) part[(kg * 9 + r) * 64 + cq * 4 + e] = acc[r][e];
    __syncthreads();
    for (int o = tid; o < 576; o += 512) {
      int r = o >> 6, col = o & 63; float s = 0.f;
      for (int g = 0; g < 32; ++g) s += part[(g * 9 + r) * 64 + col];
      MOD[(size_t)l * 9 * 9216 + (size_t)r * 9216 + n0 + col] = s + b_ada[l * 9216 + n0 + col];
    }
    __syncthreads();
  }
}

DEV void conv_T(const float* __restrict__ src, int K, int N, bf16* __restrict__ dst, int Npad, int mapmode, int rot, int vb, int nv) {
  const int tidx_ = opaque_tid();
  extern __shared__ __attribute__((aligned(16))) unsigned char smem[];
  float* tl = reinterpret_cast<float*>(smem);
  const int tid = tidx_, G = nv;
  const int nk = K / 64, nn = Npad / 64, ntiles = nk * nn;
  for (int tile = (vb + rot) % G; tile < ntiles; tile += G) {
    const int kt = tile % nk, ntile = tile / nk, k0 = kt * 64, n0 = ntile * 64;
#pragma unroll
    for (int i = 0; i < 8; ++i) { int idx = tid + i * 512, r = idx >> 6, cc = idx & 63, n = n0 + cc;
      tl[r * 65 + cc] = n < N ? __builtin_nontemporal_load(src + (size_t)(k0 + r) * N + n) : 0.f; }
    __syncthreads();
#pragma unroll
    for (int i = 0; i < 4; ++i) { int pidx = tid + i * 512, rn = pidx >> 5, ck = (pidx & 31) * 2, n = n0 + rn;
      int dr = n;
      if (mapmode == 1) { int j = n < 2816 ? n : n - 2816; int c = j & 127, a = c & 31;
        dr = (j >> 7) * 256 + (n < 2816 ? 0 : 128) + (c & ~31) + ((a >> 2) & 1) * 16 + (a >> 3) * 4 + (a & 3); }
      if (mapmode == 2) { int a = n & 31; dr = (n & ~31) + ((a >> 2) & 1) * 16 + (a >> 3) * 4 + (a & 3); }
      unsigned v = (unsigned)f2bf(tl[ck * 65 + rn]) | ((unsigned)f2bf(tl[(ck + 1) * 65 + rn]) << 16);
      __builtin_nontemporal_store(v, reinterpret_cast<unsigned*>(dst + (size_t)dr * K + k0 + ck)); }
    __syncthreads();
  }
}

DEV void conv_phase(const Params& p, int l, int vb, int nv, int part) {
  const int tidx_ = opaque_tid();
  unsigned char* ws = p.ws + (size_t)(l & 1) * WSZ;
  if (part != 2) {
    for (int j = 0; j < 2; ++j)
      conv_T(p.in[8] + (size_t)(l * 2 + j) * 1024 * 5632, 1024, 5632, reinterpret_cast<bf16*>(ws + O_WFI) + (size_t)j * 5632 * 1024, 5632, 1, j * 128, vb, nv);
  }
  if (part != 1) {
    for (int j = 0; j < 2; ++j)
      conv_T(p.in[9] + (size_t)(l * 2 + j) * 2816 * 1024, 2816, 1024, reinterpret_cast<bf16*>(ws + O_WFO) + (size_t)j * 1024 * 2816, 1024, 2, j * 192 + 64, vb, nv);
    conv_T(p.in[10] + (size_t)l * 1024 * 5792, 1024, 5792, reinterpret_cast<bf16*>(ws + O_WIN), 5888, 2, 192, vb, nv);
    for (int i = 0; i < 4; ++i)
      conv_T(p.in[29] + (size_t)(l * 4 + i) * 256 * 1024, 256, 1024, reinterpret_cast<bf16*>(ws + O_WBR) + (size_t)i * 1024 * 256, 1024, 2, i * 64, vb, nv);
    conv_T(p.in[30] + (size_t)l * 1024 * 1024, 1024, 1024, reinterpret_cast<bf16*>(ws + O_WOUT), 1024, 2, 0, vb, nv);
    conv_T(p.in[12] + (size_t)l * 256 * 384, 256, 384, reinterpret_cast<bf16*>(ws + O_WUQ), 384, 0, 0, vb, nv);
    conv_T(p.in[14] + (size_t)l * 128 * 512, 128, 512, reinterpret_cast<bf16*>(ws + O_WUKV), 512, 0, 24, vb, nv);
    conv_T(p.in[24] + (size_t)l * 256 * 512, 256, 512, reinterpret_cast<bf16*>(ws + O_WGLU), 512, 0, 40, vb, nv);
    { const float* src = p.in[27] + (size_t)l * 65536; bf16* dst = reinterpret_cast<bf16*>(ws + O_WSP);
      for (int i = vb * 512 + tidx_; i < 65536; i += nv * 512) reinterpret_cast<unsigned short*>(dst)[i] = f2bf(src[i]); }
  }
}

DEV void e_phase(const Params& p, int l, int mode, int t_begin, int t_end, int widx, int wcount, bool ctxsum) {
  const int tidx_ = opaque_tid();
  float* X = reinterpret_cast<float*>(p.ws + O_X);
  const bf16* Y = reinterpret_cast<const bf16*>(p.ws + O_Y);
  const float* YC = reinterpret_cast<const float*>(p.ws + O_Y + 37748736);
  bf16* H = reinterpret_cast<bf16*>(p.ws + (mode == 2 ? O_H2 : O_H));
  const float* MOD = reinterpret_cast<const float*>(p.ws + O_MOD);
  const float* npre = p.in[6]; const float* npost = p.in[7];
  const int lane = tidx_ & 63;
  const int sp = mode - 1; const float wgt = (sp == 1) ? 1.f : 0.5f;
  const int ln = (mode == 3) ? l + 1 : l; const int s = (mode == 3) ? 0 : mode;
  const bool final_out = (mode == 3 && l == 3);
  f32x4 xn[4], ya[4], yb[4]; us4 yh[4];
#define LOADROW(tt) do { const int t_ = (tt); \
    const float* xs_ = (mode == 0) ? (t_ < TL ? p.in[0] + (size_t)t_ * 1024 : p.in[2] + (size_t)(t_ - TL) * 1024) : X + (size_t)t_ * 1024; \
    _Pragma("unroll") for (int i = 0; i < 4; ++i) { const int c0 = i * 256 + lane * 4; \
      xn[i] = __builtin_nontemporal_load(reinterpret_cast<const f32x4*>(xs_ + c0)); \
      if (mode != 0) { if (ctxsum) { const float* yc_ = YC + (size_t)(t_ - TL) * 1024 + c0; ya[i] = *reinterpret_cast<const f32x4*>(yc_); yb[i] = *reinterpret_cast<const f32x4*>(yc_ + (size_t)2048 * 1024); } \
                       else yh[i] = ldg4(Y + (size_t)t_ * 1024 + c0); } } } while (0)
  const int rpw = (t_end - t_begin + wcount - 1) / wcount;
  int t = t_begin + widx * rpw;
  t_end = min(t_end, t + rpw);
  if (t < t_end) LOADROW(t);
  int cur_mi = -1;
  f32x4 gt[4], gg[4], g2[4], sh[4], sc[4];
  while (t < t_end) {
    const int mi = t < TL ? (t >> 11) : 8;
    if (mi != cur_mi) {
      cur_mi = mi;
      const float* gate = MOD + (size_t)l * 9 * 9216 + (size_t)mi * 9216 + (3 * sp + 2) * 1024;
      const float* gp = npost + (l * 3 + sp) * 1024;
      const float* gpre = npre + (ln * 3 + s) * 1024;
      const float* mrow = MOD + (size_t)ln * 9 * 9216 + (size_t)mi * 9216;
#pragma unroll
      for (int i = 0; i < 4; ++i) { const int c0 = i * 256 + lane * 4;
        if (mode != 0) { gt[i] = *reinterpret_cast<const f32x4*>(gate + c0); gg[i] = *reinterpret_cast<const f32x4*>(gp + c0); }
        if (!final_out) { g2[i] = *reinterpret_cast<const f32x4*>(gpre + c0);
          sh[i] = *reinterpret_cast<const f32x4*>(mrow + (3 * s) * 1024 + c0);
          sc[i] = *reinterpret_cast<const f32x4*>(mrow + (3 * s + 1) * 1024 + c0); } }
    }
    f32x4 xv[4], yv[4];
#pragma unroll
    for (int i = 0; i < 4; ++i) { xv[i] = xn[i];
      if (mode != 0) yv[i] = ctxsum ? (ya[i] + yb[i]) : (f32x4){bf2f(yh[i][0]), bf2f(yh[i][1]), bf2f(yh[i][2]), bf2f(yh[i][3])}; }
    const int tn = t + 1;
    if (tn < t_end) LOADROW(tn);
    if (mode == 0) {
#pragma unroll
      for (int i = 0; i < 4; ++i) *reinterpret_cast<f32x4*>(X + (size_t)t * 1024 + i * 256 + lane * 4) = xv[i];
    } else {
      float ss = 0.f;
#pragma unroll
      for (int i = 0; i < 4; ++i) ss += yv[i][0] * yv[i][0] + yv[i][1] * yv[i][1] + yv[i][2] * yv[i][2] + yv[i][3] * yv[i][3];
      ss = wave_sum(ss, lane);
      const float rstd = rsqrtf(ss * (1.f / 1024.f) + 1e-6f);
#pragma unroll
      for (int i = 0; i < 4; ++i) { const int c0 = i * 256 + lane * 4;
#pragma unroll
        for (int e = 0; e < 4; ++e) xv[i][e] += wgt * gt[i][e] * (yv[i][e] * rstd * gg[i][e]);
        if (!final_out) __builtin_nontemporal_store(xv[i], reinterpret_cast<f32x4*>(X + (size_t)t * 1024 + c0)); }
    }
    if (final_out) {
      if (t < TL) {
#pragma unroll
        for (int i = 0; i < 4; ++i) *reinterpret_cast<f32x4*>(p.out + (size_t)t * 1024 + i * 256 + lane * 4) = xv[i];
      }
    } else {
      float ss = 0.f;
#pragma unroll
      for (int i = 0; i < 4; ++i) ss += xv[i][0] * xv[i][0] + xv[i][1] * xv[i][1] + xv[i][2] * xv[i][2] + xv[i][3] * xv[i][3];
      ss = wave_sum(ss, lane);
      const float rstd = rsqrtf(ss * (1.f / 1024.f) + 1e-6f);
#pragma unroll
      for (int i = 0; i < 4; ++i) { const int c0 = i * 256 + lane * 4;
        float o[4];
#pragma unroll
        for (int e = 0; e < 4; ++e) o[e] = xv[i][e] * rstd * g2[i][e] * (1.f + sc[i][e]) + sh[i][e];
        __builtin_nontemporal_store(pack4(o[0], o[1], o[2], o[3]), reinterpret_cast<u32x2*>(H + (size_t)t * 1024 + c0)); }
    }
    t = tn;
  }
#undef LOADROW
}

template <int KS>
DEV void load_norm_frags(const bf16* rowptr, const float* gain, bf16x8 (&fr)[KS], int fq, int lane) {
  float v[KS][8]; float ss = 0.f;
#pragma unroll
  for (int kk = 0; kk < KS; ++kk) { bf16x8 raw = ldg8(rowptr + kk * 32 + fq * 8);
#pragma unroll
    for (int e = 0; e < 8; ++e) { v[kk][e] = bfs2f(raw[e]); ss += v[kk][e] * v[kk][e]; } }
  ss += shx(ss, 16, lane); ss += shx(ss, 32, lane);
  const float rstd = rsqrtf(ss * (1.f / (KS * 32)) + 1e-6f);
#pragma unroll
  for (int kk = 0; kk < KS; ++kk) { const float* gp = gain + kk * 32 + fq * 8;
    fr[kk] = pack8(v[kk][0] * rstd * gp[0], v[kk][1] * rstd * gp[1], v[kk][2] * rstd * gp[2], v[kk][3] * rstd * gp[3],
                   v[kk][4] * rstd * gp[4], v[kk][5] * rstd * gp[5], v[kk][6] * rstd * gp[6], v[kk][7] * rstd * gp[7]); }
}

DEV void m1_item(const Params& p, int l, int item) {
  extern __shared__ __attribute__((aligned(16))) unsigned char smem[];
  const int tidx_ = opaque_tid();
  unsigned char* ws = p.ws;
  const bf16* PROJ = reinterpret_cast<const bf16*>(ws + O_PROJ);
  bf16* KMLA = reinterpret_cast<bf16*>(ws + O_KMLA); bf16* VTMLA = reinterpret_cast<bf16*>(ws + O_VTMLA); bf16* QMLA = reinterpret_cast<bf16*>(ws + O_QMLA);
  bf16* GQ = reinterpret_cast<bf16*>(ws + O_GQ); bf16* GK = reinterpret_cast<bf16*>(ws + O_GK); bf16* GVT = reinterpret_cast<bf16*>(ws + O_GVT);
  const bf16* WUQ = reinterpret_cast<const bf16*>(ws + (size_t)(l & 1) * WSZ + O_WUQ); const bf16* WUKV = reinterpret_cast<const bf16*>(ws + (size_t)(l & 1) * WSZ + O_WUKV);
  const float* qn = p.in[11] + l * 256; const float* kvn = p.in[13] + l * 128;
  const int wv = __builtin_amdgcn_readfirstlane(tidx_ >> 6);
  constexpr int KVP = 136, QP = 264;
  unsigned short* Akv = reinterpret_cast<unsigned short*>(smem);
  unsigned short* Aq = reinterpret_cast<unsigned short*>(smem + 64 * KVP * 2);
  {
    const int lane = opaque_tid() & 63, fr = lane & 15, fq = lane >> 4;
    const int t0 = item * 64; const bool lat = t0 < TL;
    const int b = lat ? (t0 >> 11) : ((t0 - TL) >> 8);
    const int pos0 = lat ? (t0 & 2047) : 2048 + ((t0 - TL) & 255);
    {
      const int tk = (wv << 3) | (lane >> 3), part = lane & 7;
      const bf16* prow = PROJ + (size_t)(t0 + tk) * INP;
      float v[16]; float ss = 0.f;
#pragma unroll
      for (int q = 0; q < 2; ++q) { bf16x8 raw = ldg8(prow + C_KVL + part * 16 + q * 8);
#pragma unroll
        for (int e = 0; e < 8; ++e) { v[q * 8 + e] = bfs2f(raw[e]); ss += v[q * 8 + e] * v[q * 8 + e]; } }
      ss = sum8_(ss);
      float rstd = rsqrtf(ss * (1.f / 128.f) + 1e-6f);
#pragma unroll
      for (int q = 0; q < 2; ++q) { const float* gp = kvn + part * 16 + q * 8;
        *reinterpret_cast<bf16x8*>(Akv + tk * KVP + part * 16 + q * 8) =
          pack8(v[q * 8 + 0] * rstd * gp[0], v[q * 8 + 1] * rstd * gp[1], v[q * 8 + 2] * rstd * gp[2], v[q * 8 + 3] * rstd * gp[3],
                v[q * 8 + 4] * rstd * gp[4], v[q * 8 + 5] * rstd * gp[5], v[q * 8 + 6] * rstd * gp[6], v[q * 8 + 7] * rstd * gp[7]); }
      float w[32]; ss = 0.f;
#pragma unroll
      for (int q = 0; q < 4; ++q) { bf16x8 raw = ldg8(prow + C_QL + part * 32 + q * 8);
#pragma unroll
        for (int e = 0; e < 8; ++e) { w[q * 8 + e] = bfs2f(raw[e]); ss += w[q * 8 + e] * w[q * 8 + e]; } }
      ss = sum8_(ss);
      rstd = rsqrtf(ss * (1.f / 256.f) + 1e-6f);
#pragma unroll
      for (int q = 0; q < 4; ++q) { const float* gp = qn + part * 32 + q * 8;
        *reinterpret_cast<bf16x8*>(Aq + tk * QP + part * 32 + q * 8) =
          pack8(w[q * 8 + 0] * rstd * gp[0], w[q * 8 + 1] * rstd * gp[1], w[q * 8 + 2] * rstd * gp[2], w[q * 8 + 3] * rstd * gp[3],
                w[q * 8 + 4] * rstd * gp[4], w[q * 8 + 5] * rstd * gp[5], w[q * 8 + 6] * rstd * gp[6], w[q * 8 + 7] * rstd * gp[7]); }
    }
    __syncthreads();
    {
      const int h = wv >> 1, half = wv & 1;
      bf16x8 wf[4][4];
#pragma unroll
      for (int nt = 0; nt < 4; ++nt)
#pragma unroll
        for (int kk = 0; kk < 4; ++kk) wf[nt][kk] = ldg8(WUKV + (size_t)(h * 128 + half * 64 + nt * 16 + fr) * 128 + kk * 32 + fq * 8);
#pragma unroll 1
      for (int m = 0; m < 4; ++m) {
        bf16x8 af[4];
#pragma unroll
        for (int kk = 0; kk < 4; ++kk) af[kk] = *reinterpret_cast<const bf16x8*>(Akv + (m * 16 + fr) * KVP + kk * 32 + fq * 8);
#pragma unroll
        for (int nt = 0; nt < 4; ++nt) {
          f32x4 acc = {0.f, 0.f, 0.f, 0.f};
          if (half == 0) {
#pragma unroll
            for (int kk = 0; kk < 4; ++kk) acc = mfma16(wf[nt][kk], af[kk], acc);
            stg4(KMLA + ((size_t)(b * 4 + h) * NKEY + pos0 + m * 16 + fr) * 96 + nt * 16 + fq * 4, pack4(acc[0], acc[1], acc[2], acc[3]));
          } else {
#pragma unroll
            for (int kk = 0; kk < 4; ++kk) acc = mfma16(af[kk], wf[nt][kk], acc);
            stg4(VTMLA + ((size_t)(b * 4 + h) * 64 + nt * 16 + fr) * NKEY + pos0 + m * 16 + fq * 4, pack4(acc[0], acc[1], acc[2], acc[3]));
          }
        }
      }
    }
    {
      bf16x8 wq[3][8];
#pragma unroll
      for (int i = 0; i < 3; ++i)
#pragma unroll
        for (int kk = 0; kk < 8; ++kk) wq[i][kk] = ldg8(WUQ + (size_t)((wv * 3 + i) * 16 + fr) * 256 + kk * 32 + fq * 8);
#pragma unroll 1
      for (int m = 0; m < 4; ++m) {
        bf16x8 af[8];
#pragma unroll
        for (int kk = 0; kk < 8; ++kk) af[kk] = *reinterpret_cast<const bf16x8*>(Aq + (m * 16 + fr) * QP + kk * 32 + fq * 8);
#pragma unroll
        for (int i = 0; i < 3; ++i) {
          const int n = wv * 3 + i, within = n % 6;
          f32x4 acc = {0.f, 0.f, 0.f, 0.f};
#pragma unroll
          for (int kk = 0; kk < 8; ++kk) acc = mfma16(wq[i][kk], af[kk], acc);
          if (within >= 4 && lat) {
            const int pos = pos0 + m * 16 + fr; const float pa = (float)((within == 4) ? (pos >> 6) : (pos & 63));
            f32x4 o;
#pragma unroll
            for (int r = 0; r < 4; ++r) { float xp = shx(acc[r], 32, lane); o[r] = rope1(acc[r], xp, fq >= 2, pa, (fq & 1) * 4 + r, 8.f); }
            acc = o;
          }
          stg4(QMLA + (size_t)(t0 + m * 16 + fr) * 384 + n * 16 + fq * 4, pack4(acc[0], acc[1], acc[2], acc[3]));
        }
      }
    }
    {
      const int tt0 = t0 + (wv & 3) * 16, pp0 = pos0 + (wv & 3) * 16;
      if (wv < 4) {
        {
          const int tk = lane >> 2, part = lane & 3;
          const bf16* src = PROJ + (size_t)(tt0 + tk) * INP + C_KPE;
          bf16x8 raw = ldg8(src + part * 8), rawp = ldg8(src + (part ^ 1) * 8);
          bf16x8 o = raw;
          if (lat) {
            const int pos = pp0 + tk; const float pa = (float)((part < 2) ? (pos >> 6) : (pos & 63));
            float of_[8];
#pragma unroll
            for (int e = 0; e < 8; ++e) of_[e] = rope1(bfs2f(raw[e]), bfs2f(rawp[e]), (part & 1) != 0, pa, e, 8.f);
            o = pack8(of_[0], of_[1], of_[2], of_[3], of_[4], of_[5], of_[6], of_[7]);
          }
          for (int h = 0; h < 4; ++h)
            *reinterpret_cast<bf16x8*>(KMLA + ((size_t)(b * 4 + h) * NKEY + pp0 + tk) * 96 + 64 + part * 8) = o;
        }
        for (int it = 0; it < 8; ++it) {
          const int ci = lane + it * 64, tk = ci >> 5, c = ci & 31, head = c >> 3, cc = c & 7;
          const bf16* src = PROJ + (size_t)(tt0 + tk) * INP + C_GQ + head * 64;
          bf16x8 raw = ldg8(src + cc * 8), rawp = ldg8(src + (cc ^ 2) * 8), o = raw;
          if (lat) { const int pos = pp0 + tk; const float pa = (float)((cc < 4) ? (pos >> 6) : (pos & 63));
            float of_[8];
#pragma unroll
            for (int e = 0; e < 8; ++e) of_[e] = rope1(bfs2f(raw[e]), bfs2f(rawp[e]), (cc & 2) != 0, pa, (cc & 1) * 8 + e, 16.f);
            o = pack8(of_[0], of_[1], of_[2], of_[3], of_[4], of_[5], of_[6], of_[7]); }
          *reinterpret_cast<bf16x8*>(GQ + (size_t)(tt0 + tk) * 256 + head * 64 + cc * 8) = o;
        }
      } else {
        for (int it = 0; it < 4; ++it) {
          const int ci = lane + it * 64, tk = ci >> 4, c = ci & 15, kvh = c >> 3, cc = c & 7;
          const bf16* src = PROJ + (size_t)(tt0 + tk) * INP + C_GK + kvh * 64;
          bf16x8 raw = ldg8(src + cc * 8), rawp = ldg8(src + (cc ^ 2) * 8), o = raw;
          if (lat) { const int pos = pp0 + tk; const float pa = (float)((cc < 4) ? (pos >> 6) : (pos & 63));
            float of_[8];
#pragma unroll
            for (int e = 0; e < 8; ++e) of_[e] = rope1(bfs2f(raw[e]), bfs2f(rawp[e]), (cc & 2) != 0, pa, (cc & 1) * 8 + e, 16.f);
            o = pack8(of_[0], of_[1], of_[2], of_[3], of_[4], of_[5], of_[6], of_[7]); }
          *reinterpret_cast<bf16x8*>(GK + ((size_t)(b * 2 + kvh) * NKEY + pp0 + tk) * 64 + cc * 8) = o;
        }
        for (int it = 0; it < 2; ++it) {
          const int ch = lane + it * 64, kvh = ch >> 6, d = ch & 63;
          const unsigned short* src = reinterpret_cast<const unsigned short*>(PROJ) + (size_t)tt0 * INP + C_GV + ch;
          bf16x8 o0, o1;
#pragma unroll
          for (int k = 0; k < 8; ++k) { o0[k] = (short)src[(size_t)k * INP]; o1[k] = (short)src[(size_t)(k + 8) * INP]; }
          bf16* dst = GVT + ((size_t)(b * 2 + kvh) * 64 + d) * NKEY + pp0;
          *reinterpret_cast<bf16x8*>(dst) = o0; *reinterpret_cast<bf16x8*>(dst + 8) = o1;
        }
      }
    }
    __syncthreads();
  }
}

template <int KS>
DEV void attn_chunk(const unsigned char* Kl, const unsigned char* Vl, const bf16x8 (&qf)[2][KS], f32x4 (&O)[2][4], float (&mrun)[2], float (&lrun)[2],
                    bool masked, int key0, int qw0, float sl2, int lane, int fr, int fq) {
  constexpr int DK = KS * 32, KP = DK + 8, VP = 72;
  f32x4 sc[2][4];
#pragma unroll
  for (int kt = 0; kt < 4; ++kt) {
    sc[0][kt] = (f32x4){0.f, 0.f, 0.f, 0.f}; sc[1][kt] = (f32x4){0.f, 0.f, 0.f, 0.f};
#pragma unroll
    for (int kk = 0; kk < KS; ++kk) {
      bf16x8 kf = *reinterpret_cast<const bf16x8*>(Kl + ((kt * 16 + fr) * KP + kk * 32 + fq * 8) * 2);
      sc[0][kt] = mfma16(kf, qf[0][kk], sc[0][kt]); sc[1][kt] = mfma16(kf, qf[1][kk], sc[1][kt]);
    }
  }
  bf16x8 pf[2][2];
#pragma unroll
  for (int qi = 0; qi < 2; ++qi) {
    float mx = -1e30f;
#pragma unroll
    for (int kt = 0; kt < 4; ++kt)
#pragma unroll
      for (int r = 0; r < 4; ++r) { float v = sc[qi][kt][r] * sl2;
        if (masked) { int kp = key0 + kt * 16 + fq * 4 + r; int dq = qw0 + qi * 16 + fr - kp; if (dq > 128 || dq < -128) v = -1e30f; }
        sc[qi][kt][r] = v; mx = fmaxf(mx, v); }
    mx = max_x16_x32(mx);
    const float mnew = fmaxf(mrun[qi], mx);
    const float alpha = __builtin_amdgcn_exp2f(mrun[qi] - mnew);
    mrun[qi] = mnew;
    float ps = 0.f;
#pragma unroll
    for (int kt = 0; kt < 4; ++kt)
#pragma unroll
      for (int r = 0; r < 4; ++r) { float pvv = __builtin_amdgcn_exp2f(sc[qi][kt][r] - mnew); ps += pvv; sc[qi][kt][r] = pvv; }
    pf[qi][0] = pack8(sc[qi][0][0], sc[qi][0][1], sc[qi][0][2], sc[qi][0][3], sc[qi][1][0], sc[qi][1][1], sc[qi][1][2], sc[qi][1][3]);
    pf[qi][1] = pack8(sc[qi][2][0], sc[qi][2][1], sc[qi][2][2], sc[qi][2][3], sc[qi][3][0], sc[qi][3][1], sc[qi][3][2], sc[qi][3][3]);
    lrun[qi] = lrun[qi] * alpha + ps;
#pragma unroll
    for (int dt = 0; dt < 4; ++dt) O[qi][dt] *= alpha;
  }
#pragma unroll
  for (int dt = 0; dt < 4; ++dt)
#pragma unroll
    for (int sub = 0; sub < 2; ++sub) {
      const unsigned char* vp = Vl + ((dt * 16 + fr) * VP + sub * 32 + fq * 4) * 2;
      u32x2 v0 = *reinterpret_cast<const u32x2*>(vp), v1 = *reinterpret_cast<const u32x2*>(vp + 32);
      u32x4 vv = {v0[0], v0[1], v1[0], v1[1]};
      bf16x8 vf = *reinterpret_cast<bf16x8*>(&vv);
      O[0][dt] = mfma16(vf, pf[0][sub], O[0][dt]); O[1][dt] = mfma16(vf, pf[1][sub], O[1][dt]);
    }
}

template <int KS>
DEV void attn_block(const bf16* Q, int ldq, const bf16* Kb, const bf16* Vt, int a_lo, int a_hi, int b_lo, int b_hi, bool maskA, int qpos_blk,
                    float scale, bool has_sink, float sink, bf16* out, int ldo) {
  extern __shared__ __attribute__((aligned(16))) unsigned char smem[];
  const int tidx_ = opaque_tid();
  constexpr int DK = KS * 32, KP = DK + 8, VP = 72, KV8 = DK / 8;
  constexpr int KBYTES = 64 * KP * 2, VBYTES = 64 * VP * 2;
  const int lane = tidx_ & 63, wv = __builtin_amdgcn_readfirstlane(tidx_ >> 6), fr = lane & 15, fq = lane >> 4;
  const float L2E = 1.4426950408889634f;
  const bf16* Qw = Q + (size_t)(wv * 32) * ldq;
  bf16x8 qf[2][KS];
#pragma unroll
  for (int qi = 0; qi < 2; ++qi)
#pragma unroll
    for (int kk = 0; kk < KS; ++kk) qf[qi][kk] = ldg8(Qw + (size_t)(qi * 16 + fr) * ldq + kk * 32 + fq * 8);
  f32x4 O[2][4];
  float mrun[2], lrun[2];
  const float sl2 = scale * L2E;
#pragma unroll
  for (int qi = 0; qi < 2; ++qi) { mrun[qi] = has_sink ? sink * L2E : -1e30f; lrun[qi] = (has_sink && fq == 0) ? 1.f : 0.f;
#pragma unroll
    for (int dt = 0; dt < 4; ++dt) O[qi][dt] = (f32x4){0.f, 0.f, 0.f, 0.f}; }
  const int nA = a_hi - a_lo, nB = b_hi - b_lo, n = nA + nB;
  const int qw0 = qpos_blk + wv * 32;
  const int kv0 = tidx_, kv1 = tidx_ + 512;
  const int kr0 = kv0 / KV8, kc0 = kv0 % KV8, kr1 = kv1 / KV8, kc1 = kv1 % KV8;
  const bool has1 = kv1 < 64 * KV8;
  const int vd = tidx_ >> 3, vpart = tidx_ & 7;
  const int koff0 = (kr0 * KP + kc0 * 8) * 2, koff1 = (kr1 * KP + kc1 * 8) * 2, voff = 2 * KBYTES + (vd * VP + vpart * 8) * 2;
  bf16x8 a0, a1, av, b0, b1, bv;
  a1 = (bf16x8){0, 0, 0, 0, 0, 0, 0, 0}; b0 = a1; b1 = a1; bv = a1;
#define CH_OF(i_) ((i_) < nA ? a_lo + (i_) : b_lo + ((i_) - nA))
#define LOADSET(r0_, r1_, rv_, i_) do { const int kn_ = CH_OF(i_) * 64; \
    r0_ = ldg8(Kb + (size_t)(kn_ + kr0) * DK + kc0 * 8); if (has1) r1_ = ldg8(Kb + (size_t)(kn_ + kr1) * DK + kc1 * 8); \
    rv_ = ldg8(Vt + (size_t)vd * NKEY + kn_ + vpart * 8); } while (0)
#define STORESET(r0_, r1_, rv_, i_) do { unsigned char* kb_ = smem + ((i_) & 1) * KBYTES; \
    *reinterpret_cast<bf16x8*>(kb_ + koff0) = r0_; if (has1) *reinterpret_cast<bf16x8*>(kb_ + koff1) = r1_; \
    *reinterpret_cast<bf16x8*>(smem + voff + ((i_) & 1) * VBYTES) = rv_; } while (0)
#define BODY(it_, L0, L1, LV, S0, S1, SV) do { \
    if ((it_) + 2 < n) LOADSET(L0, L1, LV, (it_) + 2); \
    { const int c_ = CH_OF(it_); const bool masked_ = maskA && ((it_) < nA); const int key0_ = c_ * 64; \
      const bool active_ = !masked_ || !(key0_ + 63 < qw0 - 128 || key0_ > qw0 + 159); \
      if (active_) attn_chunk<KS>(smem + ((it_) & 1) * KBYTES, smem + 2 * KBYTES + ((it_) & 1) * VBYTES, qf, O, mrun, lrun, masked_, key0_, qw0, sl2, lane, fr, fq); } \
    if ((it_) + 1 < n) STORESET(S0, S1, SV, (it_) + 1); \
    asm volatile("s_waitcnt lgkmcnt(0)" ::: "memory"); __builtin_amdgcn_s_barrier(); asm volatile("" ::: "memory"); } while (0)
  LOADSET(a0, a1, av, 0);
  STORESET(a0, a1, av, 0);
  if (n > 1) LOADSET(b0, b1, bv, 1);
  __syncthreads();
#pragma unroll 1
  for (int it = 0; it < n; it += 2) {
    BODY(it, a0, a1, av, b0, b1, bv);
    if (it + 1 < n) BODY(it + 1, b0, b1, bv, a0, a1, av);
  }
#undef BODY
#undef LOADSET
#undef STORESET
#undef CH_OF
  bf16* outw = out + (size_t)(wv * 32) * ldo;
#pragma unroll
  for (int qi = 0; qi < 2; ++qi) {
    const float l = sum_x16_x32(lrun[qi]);
    const float inv = 1.f / l;
#pragma unroll
    for (int dt = 0; dt < 4; ++dt)
      stg4(outw + (size_t)(qi * 16 + fr) * ldo + dt * 16 + fq * 4, pack4(O[qi][dt][0] * inv, O[qi][dt][1] * inv, O[qi][dt][2] * inv, O[qi][dt][3] * inv));
  }
}

DEV void mla_item(const Params& p, int i) {
  const bf16* KMLA = reinterpret_cast<const bf16*>(p.ws + O_KMLA); const bf16* VTMLA = reinterpret_cast<const bf16*>(p.ws + O_VTMLA);
  const bf16* QMLA = reinterpret_cast<const bf16*>(p.ws + O_QMLA); bf16* YBR = reinterpret_cast<bf16*>(p.ws + O_H);
  int b, h, t, lo, hi;
  if (i < 256) { b = i >> 5; h = (i >> 3) & 3; t = b * 2048 + (i & 7) * 256; lo = 0; hi = 36; }
  else { int j = i - 256; b = j >> 2; h = j & 3; t = TL + b * 256; lo = 32; hi = 36; }
  attn_block<3>(QMLA + (size_t)t * 384 + h * 96, 384, KMLA + (size_t)(b * 4 + h) * NKEY * 96, VTMLA + (size_t)(b * 4 + h) * 64 * NKEY,
                lo, hi, 0, 0, false, 0, 0.10206207261596577f, false, 0.f, YBR + (size_t)t * 256 + h * 64, 256);
}
DEV void gqa_item(const Params& p, int l, int i) {
  const bf16* GQ = reinterpret_cast<const bf16*>(p.ws + O_GQ); const bf16* GK = reinterpret_cast<const bf16*>(p.ws + O_GK);
  const bf16* GVT = reinterpret_cast<const bf16*>(p.ws + O_GVT); bf16* YBR1 = reinterpret_cast<bf16*>(p.ws + O_H) + (size_t)T * 256;
  int b, hq, t, alo = 0, ahi = 0, qp = 0;
  if (i < 256) { b = i >> 5; hq = (i >> 3) & 3; qp = (i & 7) * 256; t = b * 2048 + qp;
    alo = max(0, qp - 128) >> 6; ahi = (min(2047, qp + 383) >> 6) + 1; }
  else { int j = i - 256; b = j >> 2; hq = j & 3; t = TL + b * 256; }
  const int kvh = hq >> 1;
  const float sink = p.in[15][l * 4 + hq];
  attn_block<2>(GQ + (size_t)t * 256 + hq * 64, 256, GK + (size_t)(b * 2 + kvh) * NKEY * 64, GVT + (size_t)(b * 2 + kvh) * 64 * NKEY,
                alo, ahi, 32, 36, true, qp, 0.125f, true, sink, YBR1 + (size_t)t * 256 + hq * 64, 256);
}

DEV int s5_token(int b, int dir, int s) {
  if (s < 256) { int pos = dir ? 255 - s : s; return TL + b * 256 + pos; }
  int q = s - 256; int pos = dir ? 2047 - q : q; return b * 2048 + pos;
}
DEV void s5_disc(const Params& p, int gi, int pp, float& a_re, float& a_im, float& cre, float& cim) {
  float lre = fminf(p.in[16][gi * 64 + pp], -1e-4f), lim = p.in[17][gi * 64 + pp];
  const float dt = expf(p.in[18][gi]);
  const float mag = expf(lre * dt);
  float sn, cs; sincos_acc(lim * dt, sn, cs);
  a_re = mag * cs; a_im = mag * sn;
  const float nr = a_re - 1.f, ni = a_im, den = lre * lre + lim * lim;
  cre = (nr * lre + ni * lim) / den; cim = (ni * lre - nr * lim) / den;
}
DEV void s5_item(const Params& p, int l, int item) {
  extern __shared__ __attribute__((aligned(16))) unsigned char smem[];
  const int tidx_ = opaque_tid();
  const int b = item >> 5, g = (item >> 1) & 15, dir = item & 1;
  const int lane = tidx_ & 63, wv = __builtin_amdgcn_readfirstlane(tidx_ >> 6), fr = lane & 15, fq = lane >> 4;
  constexpr int WB = 12800, BUP = 132;
  float* Bu = reinterpret_cast<float*>(smem + wv * WB);
  unsigned short* Sst = reinterpret_cast<unsigned short*>(smem + wv * WB + 8448);
  float* Ex = reinterpret_cast<float*>(smem + 8 * WB);
  const bf16* PROJ = reinterpret_cast<const bf16*>(p.ws + O_PROJ);
  float* S5Y = reinterpret_cast<float*>(p.ws + O_Y) + (size_t)dir * T * 256;
  const int gi = (l * 2 + dir) * 16 + g;
  float a_re, a_im, cre_, cim_;
  s5_disc(p, gi, lane, a_re, a_im, cre_, cim_);
  bf16x8 bbf[8];
#pragma unroll
  for (int tl = 0; tl < 4; ++tl) {
    const int pp = tl * 16 + fr;
    float ar2, ai2, cr2, ci2; s5_disc(p, gi, pp, ar2, ai2, cr2, ci2);
    float vr[8], vi[8];
    const float* br = p.in[19] + ((size_t)gi * 64 + pp) * 16 + (fq & 1) * 8; const float* bi = p.in[20] + ((size_t)gi * 64 + pp) * 16 + (fq & 1) * 8;
#pragma unroll
    for (int e = 0; e < 8; ++e) { const float r0 = br[e], i0 = bi[e]; vr[e] = (fq < 2) ? (cr2 * r0 - ci2 * i0) : 0.f; vi[e] = (fq < 2) ? (cr2 * i0 + ci2 * r0) : 0.f; }
    bbf[tl] = pack8(vr[0], vr[1], vr[2], vr[3], vr[4], vr[5], vr[6], vr[7]);
    bbf[4 + tl] = pack8(vi[0], vi[1], vi[2], vi[3], vi[4], vi[5], vi[6], vi[7]);
  }
  bf16x8 cf[4];
#pragma unroll
  for (int kk = 0; kk < 4; ++kk) {
    const float* src = (kk < 2 ? p.in[21] : p.in[22]) + ((size_t)gi * 16 + fr) * 64 + (kk & 1) * 32 + fq * 8;
    const float sg = kk < 2 ? 1.f : -1.f;
    cf[kk] = pack8(sg * src[0], sg * src[1], sg * src[2], sg * src[3], sg * src[4], sg * src[5], sg * src[6], sg * src[7]);
  }
  const int sbase = wv * 288;
  float sre = 0.f, sim = 0.f;
#pragma unroll 1
  for (int pass = 0; pass < 2; ++pass) {
    bf16x8 uf = (bf16x8){0, 0, 0, 0, 0, 0, 0, 0};
    if (fq < 2) uf = ldg8(PROJ + (size_t)s5_token(b, dir, sbase + fr) * INP + C_U + g * 16 + fq * 8);
#pragma unroll 1
    for (int sc = 0; sc < 18; ++sc) {
      const int s0 = sbase + sc * 16;
#pragma unroll
      for (int tl = 0; tl < 8; ++tl) {
        f32x4 d = mfma16(uf, bbf[tl], (f32x4){0.f, 0.f, 0.f, 0.f});
#pragma unroll
        for (int r = 0; r < 4; ++r) Bu[(fq * 4 + r) * BUP + tl * 16 + fr] = d[r];
      }
      if (sc + 1 < 18) { if (fq < 2) uf = ldg8(PROJ + (size_t)s5_token(b, dir, s0 + 16 + fr) * INP + C_U + g * 16 + fq * 8); }
      float bur[16], bui[16];
#pragma unroll
      for (int tt = 0; tt < 16; ++tt) { bur[tt] = Bu[tt * BUP + lane]; bui[tt] = Bu[tt * BUP + 64 + lane]; }
      if (pass == 0) {
#pragma unroll
        for (int tt = 0; tt < 16; ++tt) {
          const float nre = a_re * sre - a_im * sim + bur[tt], nim = a_re * sim + a_im * sre + bui[tt];
          sre = nre; sim = nim;
        }
      } else {
#pragma unroll
        for (int tt = 0; tt < 16; ++tt) {
          const float nre = a_re * sre - a_im * sim + bur[tt], nim = a_re * sim + a_im * sre + bui[tt];
          sre = nre; sim = nim;
          const unsigned pk = pk2(sre, sim); Sst[tt * 136 + lane] = (unsigned short)(pk & 0xffffu); Sst[tt * 136 + 64 + lane] = (unsigned short)(pk >> 16);
        }
      }
      if (pass == 1) {
        f32x4 acc = {0.f, 0.f, 0.f, 0.f};
#pragma unroll
        for (int kk = 0; kk < 4; ++kk) { bf16x8 sf = *reinterpret_cast<const bf16x8*>(Sst + fr * 136 + kk * 32 + fq * 8); acc = mfma16(cf[kk], sf, acc); }
        const int tok = s5_token(b, dir, s0 + fr);
        *reinterpret_cast<f32x4*>(S5Y + (size_t)tok * 256 + g * 16 + fq * 4) = acc;
      }
    }
    if (pass == 0) {
      Ex[wv * 128 + lane] = sre; Ex[wv * 128 + 64 + lane] = sim;
      __syncthreads();
      float pr = 1.f, pi = 0.f;
#pragma unroll 1
      for (int i = 0; i < 288; ++i) { float t1 = pr * a_re - pi * a_im, t2 = pr * a_im + pi * a_re; pr = t1; pi = t2; }
      float cr = 0.f, ci = 0.f;
      for (int w2 = 0; w2 < wv; ++w2) { float er = Ex[w2 * 128 + lane], ei = Ex[w2 * 128 + 64 + lane];
        float t1 = pr * cr - pi * ci + er, t2 = pr * ci + pi * cr + ei; cr = t1; ci = t2; }
      sre = cr; sim = ci;
    }
  }
}

DEV void gmlp_item(const Params& p, int l, int item) {
  const int tidx_ = opaque_tid();
  extern __shared__ __attribute__((aligned(16))) unsigned char smem[];
  unsigned short* vT = reinterpret_cast<unsigned short*>(smem);
  const bf16* PROJ = reinterpret_cast<const bf16*>(p.ws + O_PROJ);
  const bf16* WS = reinterpret_cast<const bf16*>(p.ws + (size_t)(l & 1) * WSZ + O_WSP);
  bf16* YBR3 = reinterpret_cast<bf16*>(p.ws + O_H) + (size_t)3 * T * 256;
  const float* gn = p.in[26] + l * 256; const float* bs = p.in[28] + l * 512;
  const int lane = tidx_ & 63, wv = __builtin_amdgcn_readfirstlane(tidx_ >> 6), fr = lane & 15, fq = lane >> 4;
  const int t0 = item * 128;
  f32x4 g4 = *reinterpret_cast<const f32x4*>(gn + lane * 4);
  us4 raws[16];
#pragma unroll
  for (int i = 0; i < 16; ++i) raws[i] = ldg4(PROJ + (size_t)(t0 + wv * 16 + i) * INP + C_Z + 256 + lane * 4);
#pragma unroll
  for (int i = 0; i < 16; ++i) {
    const int tk = wv * 16 + i;
    const us4 raw = raws[i];
    float v[4]; float s = 0.f;
#pragma unroll
    for (int e = 0; e < 4; ++e) { v[e] = geluf_(bf2f(raw[e])); s += v[e]; }
    const float mean = wave_sum(s, lane) * (1.f / 256.f);
    float q = 0.f;
#pragma unroll
    for (int e = 0; e < 4; ++e) { v[e] -= mean; q += v[e] * v[e]; }
    const float rstd = rsqrtf(wave_sum(q, lane) * (1.f / 256.f) + 1e-5f);
#pragma unroll
    for (int e = 0; e < 4; ++e) vT[(lane * 4 + e) * 136 + tk] = f2bf(v[e] * rstd * g4[e]);
  }
  __syncthreads();
  const int i0 = wv * 16; const int tok = t0 + i0 + fr;
#pragma unroll 1
  for (int g = 0; g < 4; ++g) {
  bf16x8 wf[4]; us4 urs[4];
#pragma unroll
  for (int kk = 0; kk < 4; ++kk) wf[kk] = ldg8(WS + (size_t)(g * 128 + i0 + fr) * 128 + kk * 32 + fq * 8);
#pragma unroll
  for (int c4 = 0; c4 < 4; ++c4) urs[c4] = ldg4(PROJ + (size_t)tok * INP + C_Z + (g * 4 + c4) * 16 + fq * 4);
  const float bias = bs[g * 128 + i0 + fr];
#pragma unroll
  for (int c4 = 0; c4 < 4; ++c4) {
    const int ct = g * 4 + c4;
    f32x4 acc = {0.f, 0.f, 0.f, 0.f};
#pragma unroll
    for (int kk = 0; kk < 4; ++kk) {
      bf16x8 af = *reinterpret_cast<const bf16x8*>(vT + (ct * 16 + fr) * 136 + kk * 32 + fq * 8);
      acc = mfma16(af, wf[kk], acc);
    }
    const us4 ur = urs[c4];
    stg4(YBR3 + (size_t)tok * 256 + ct * 16 + fq * 4,
         pack4(geluf_(bf2f(ur[0])) * (acc[0] + bias), geluf_(bf2f(ur[1])) * (acc[1] + bias), geluf_(bf2f(ur[2])) * (acc[2] + bias), geluf_(bf2f(ur[3])) * (acc[3] + bias)));
  }
  }
}

DEV void flag_arrive(unsigned* flag);
DEV void flag_wait(unsigned* flag, unsigned need);
DEV void m3_item(const Params& p, int l, int item) {
  extern __shared__ __attribute__((aligned(16))) unsigned char smem[];
  const int tidx_ = opaque_tid();
  const bf16* PROJ = reinterpret_cast<const bf16*>(p.ws + O_PROJ);
  const float* Y0 = reinterpret_cast<const float*>(p.ws + O_Y); const float* Y1 = Y0 + (size_t)T * 256;
  const bf16* WGLU = reinterpret_cast<const bf16*>(p.ws + (size_t)(l & 1) * WSZ + O_WGLU);
  bf16* YBR2 = reinterpret_cast<bf16*>(p.ws + O_H) + (size_t)2 * T * 256;
  const float* dsk = p.in[23] + l * 256; const float* bg = p.in[25] + l * 512;
  const int lane = tidx_ & 63, wv = __builtin_amdgcn_readfirstlane(tidx_ >> 6), fr = lane & 15, fq = lane >> 4;
  constexpr int AP = 264;
  unsigned short* As = reinterpret_cast<unsigned short*>(smem);
  {
    const int t0 = item * 64;
    {
      const int tk = tidx_ >> 3, c0 = (tidx_ & 7) * 32; const int tok = t0 + tk;
#pragma unroll
      for (int q = 0; q < 4; ++q) {
        const int ch0 = c0 + q * 8;
        bf16x8 ur = ldg8(PROJ + (size_t)tok * INP + C_U + ch0);
        float gv[8];
#pragma unroll
        for (int hh = 0; hh < 2; ++hh) {
          f32x4 y0 = *reinterpret_cast<const f32x4*>(Y0 + (size_t)tok * 256 + ch0 + hh * 4);
          f32x4 y1 = *reinterpret_cast<const f32x4*>(Y1 + (size_t)tok * 256 + ch0 + hh * 4);
          f32x4 d4 = *reinterpret_cast<const f32x4*>(dsk + ch0 + hh * 4);
#pragma unroll
          for (int e = 0; e < 4; ++e) gv[hh * 4 + e] = geluf_(y0[e] + y1[e] + d4[e] * bfs2f(ur[hh * 4 + e]));
        }
        *reinterpret_cast<bf16x8*>(As + tk * AP + ch0) = pack8(gv[0], gv[1], gv[2], gv[3], gv[4], gv[5], gv[6], gv[7]);
      }
    }
    __syncthreads();
    f32x4 aa[4][2], ag[4][2];
#pragma unroll
    for (int m = 0; m < 4; ++m)
#pragma unroll
      for (int n = 0; n < 2; ++n) { aa[m][n] = (f32x4){0.f, 0.f, 0.f, 0.f}; ag[m][n] = (f32x4){0.f, 0.f, 0.f, 0.f}; }
#pragma unroll 2
    for (int kk = 0; kk < 8; ++kk) {
      bf16x8 wa[2], wg[2], af[4];
#pragma unroll
      for (int n = 0; n < 2; ++n) { const int nt = wv + n * 8;
        wa[n] = ldg8(WGLU + (size_t)(nt * 16 + fr) * 256 + kk * 32 + fq * 8);
        wg[n] = ldg8(WGLU + (size_t)(256 + nt * 16 + fr) * 256 + kk * 32 + fq * 8); }
#pragma unroll
      for (int m = 0; m < 4; ++m) af[m] = *reinterpret_cast<const bf16x8*>(As + (m * 16 + fr) * AP + kk * 32 + fq * 8);
#pragma unroll
      for (int m = 0; m < 4; ++m)
#pragma unroll
        for (int n = 0; n < 2; ++n) { aa[m][n] = mfma16(wa[n], af[m], aa[m][n]); ag[m][n] = mfma16(wg[n], af[m], ag[m][n]); }
    }
#pragma unroll
    for (int n = 0; n < 2; ++n) {
      const int ncol = (wv + n * 8) * 16 + fq * 4;
      f32x4 ba = *reinterpret_cast<const f32x4*>(bg + ncol), bgg = *reinterpret_cast<const f32x4*>(bg + 256 + ncol);
#pragma unroll
      for (int m = 0; m < 4; ++m) {
        const int tok = t0 + m * 16 + fr;
        float o[4];
#pragma unroll
        for (int r = 0; r < 4; ++r) o[r] = (aa[m][n][r] + ba[r]) * sigmoidf_(ag[m][n][r] + bgg[r]);
        stg4(YBR2 + (size_t)tok * 256 + ncol, pack4(o[0], o[1], o[2], o[3]));
      }
    }
    __syncthreads();
  }
}

DEV void m2_phase(const Params& p, int l) {
  extern __shared__ __attribute__((aligned(16))) unsigned char smem[];
  const bool last = (l == 3);
  volatile unsigned* nxt = reinterpret_cast<volatile unsigned*>(smem + 131072 + 32);
  unsigned* counter = reinterpret_cast<unsigned*>(p.ws + O_BAR) + 3712 + l;
  const int total = last ? (256 + 256 + 128) : (256 + 256 + 144 + 32 + 32);
  unsigned* s5flag = reinterpret_cast<unsigned*>(p.ws + O_BAR) + 3720 + l * 8;
  unsigned* m1flag = reinterpret_cast<unsigned*>(p.ws + O_BAR) + 3752 + l * 8;
  for (int item = blockIdx.x; item < T / 64; item += gridDim.x) { m1_item(p, l, item); flag_arrive(m1flag + (item < 256 ? (item >> 5) : ((item - 256) >> 2))); __syncthreads(); }
  for (int item = blockIdx.x; item < 256; item += gridDim.x) { s5_item(p, l, item); flag_arrive(s5flag + (item >> 5)); __syncthreads(); }
  unsigned seen = 0u;
#define NEED_M1(b_) do { const int bb_ = (b_); if (!((seen >> bb_) & 1u)) { flag_wait(m1flag + bb_, 36u); seen |= 1u << bb_; } } while (0)
  const int n3 = last ? 256 : 288;
  for (;;) {
    if (threadIdx.x == 0) *nxt = __hip_atomic_fetch_add(counter, 1u, __ATOMIC_RELAXED, __HIP_MEMORY_SCOPE_AGENT);
    __syncthreads();
    const int q = (int)*nxt;
    __syncthreads();
    if (q >= total + n3) break;
    if (q >= total) {
      const int i3 = q - total; const int b3 = i3 < 256 ? (i3 >> 5) : ((i3 - 256) >> 2);
      flag_wait(s5flag + b3, 32u);
      m3_item(p, l, i3);
    }
    else if (q < 256) { NEED_M1(q >> 5); mla_item(p, q); }
    else if (q < 512) { NEED_M1((q - 256) >> 5); gqa_item(p, l, q - 256); }
    else if (last) gmlp_item(p, l, q - 512);
    else if (q < 656) gmlp_item(p, l, q - 512);
    else if (q < 688) { NEED_M1((q - 656) >> 2); mla_item(p, 256 + (q - 656)); }
    else { NEED_M1((q - 688) >> 2); gqa_item(p, l, 256 + (q - 688)); }
    __syncthreads();
  }
#undef NEED_M1
}

#define XB_TMO      128
#define XB_XCNT(j)  (256  + 64 * (j))
#define XB_XSUB(j)  (1280 + 64 * (j))
#define XB_XGEN(j)  (2304 + 64 * (j))
#define XB_TOP      3328
#define XB_TOPGEN   3392
#define XCD_BAR_WORDS 3456
#define XB_SPIN_CAP (1u << 22)
#define LAS __attribute__((address_space(3)))
DEV unsigned xb_ld(unsigned* p) { return __hip_atomic_load(p, __ATOMIC_RELAXED, __HIP_MEMORY_SCOPE_AGENT); }
DEV unsigned xb_add(unsigned* p, unsigned v) { return __hip_atomic_fetch_add(p, v, __ATOMIC_RELAXED, __HIP_MEMORY_SCOPE_AGENT); }
DEV unsigned xb_xcc_id() { return (unsigned)__builtin_amdgcn_s_getreg((3 << 11) | 20) & 0xFu; }
#define XB_SPIN(cond, bar) do { unsigned _sp = 0; while (cond) { __builtin_amdgcn_s_sleep(1); \
    if ((++_sp & 255u) == 0u) { if (xb_ld(&(bar)[XB_TMO])) break; if (_sp > XB_SPIN_CAP) { atomicAdd(&(bar)[XB_TMO], 1u); break; } } } } while (0)
struct XcdBarrier { unsigned* bar; unsigned x; volatile LAS unsigned* st; };
DEV XcdBarrier xcd_barrier_post(unsigned* bar, volatile LAS unsigned* st) {
  XcdBarrier b; b.bar = bar; b.x = xb_xcc_id(); b.st = st;
  if (threadIdx.x == 0) (void)xb_add(&bar[XB_XCNT(b.x)], 1u);
  return b;
}
DEV void xcd_barrier_complete(unsigned* bar, unsigned x, unsigned& nloc, unsigned& nx) {
  const unsigned G = gridDim.x * gridDim.y * gridDim.z;
  unsigned sum, cnt, mine, sp = 0u;
  for (;;) {
    sum = 0u; cnt = 0u; mine = 0u;
#pragma unroll
    for (unsigned j = 0; j < 16; ++j) { const unsigned c = xb_ld(&bar[XB_XCNT(j)]); sum += c; cnt += (c > 0u) ? 1u : 0u; mine = (j == x) ? c : mine; }
    if (sum == G) break;
    __builtin_amdgcn_s_sleep(1);
    if ((++sp & 255u) == 0u) { if (xb_ld(&bar[XB_TMO])) break; if (sp > XB_SPIN_CAP) { atomicAdd(&bar[XB_TMO], 1u); break; } }
  }
  nloc = mine > 0u ? mine : 1u; nx = cnt > 0u ? cnt : 1u;
}
DEV void xcd_barrier(const XcdBarrier& b) {
  asm volatile("s_waitcnt vmcnt(0)" ::: "memory");
  __syncthreads();
  if (threadIdx.x == 0) {
    unsigned* bar = b.bar;
    __builtin_amdgcn_s_waitcnt(0);
    unsigned nloc = b.st[0], nx = b.st[1];
    if (nloc == 0u) { xcd_barrier_complete(bar, b.x, nloc, nx); b.st[0] = nloc; b.st[1] = nx; }
    const unsigned old = xb_add(&bar[XB_XSUB(b.x)], 1u);
    const unsigned gen = old / nloc;
    if (old + 1u == (gen + 1u) * nloc) {
      __builtin_amdgcn_fence(__ATOMIC_RELEASE, "agent");
      asm volatile("s_waitcnt vmcnt(0)" ::: "memory");
      const unsigned og = xb_add(&bar[XB_TOP], 1u);
      const unsigned tg = og / nx;
      if (og + 1u == (tg + 1u) * nx) xb_add(&bar[XB_TOPGEN], 1u);
      else XB_SPIN(xb_ld(&bar[XB_TOPGEN]) == tg, bar);
      __builtin_amdgcn_fence(__ATOMIC_ACQUIRE, "agent");
      xb_add(&bar[XB_XGEN(b.x)], 1u);
      asm volatile("s_waitcnt vmcnt(0)" ::: "memory");
    } else {
      XB_SPIN(xb_ld(&bar[XB_XGEN(b.x)]) == gen, bar);
      __builtin_amdgcn_fence(__ATOMIC_ACQUIRE, "agent");
      asm volatile("s_waitcnt vmcnt(0)" ::: "memory");
    }
  }
  __syncthreads();
}

DEV void signal_wait(unsigned* flag, unsigned need) {
  asm volatile("s_waitcnt vmcnt(0)" ::: "memory");
  __syncthreads();
  if (threadIdx.x == 0) {
    __builtin_amdgcn_fence(__ATOMIC_RELEASE, "agent");
    asm volatile("s_waitcnt vmcnt(0)" ::: "memory");
    xb_add(flag, 1u);
    unsigned sp = 0;
    while (xb_ld(flag) < need) { __builtin_amdgcn_s_sleep(2); if (++sp > (1u << 24)) break; }
    __builtin_amdgcn_fence(__ATOMIC_ACQUIRE, "agent");
    asm volatile("s_waitcnt vmcnt(0)" ::: "memory");
  }
  __syncthreads();
}

DEV void flag_arrive(unsigned* flag) {
  asm volatile("s_waitcnt vmcnt(0)" ::: "memory");
  __syncthreads();
  if (threadIdx.x == 0) {
    __builtin_amdgcn_fence(__ATOMIC_RELEASE, "agent");
    asm volatile("s_waitcnt vmcnt(0)" ::: "memory");
    xb_add(flag, 1u);
  }
}
DEV void flag_wait(unsigned* flag, unsigned need) {
  if (threadIdx.x == 0) {
    unsigned sp = 0;
    while (xb_ld(flag) < need) { __builtin_amdgcn_s_sleep(2); if (++sp > (1u << 24)) break; }
    __builtin_amdgcn_fence(__ATOMIC_ACQUIRE, "agent");
    asm volatile("s_waitcnt vmcnt(0)" ::: "memory");
  }
  __syncthreads();
}

constexpr int NPHASE = 2 + 13 * 4;

DEV void run_phase(const Params& p, int ph) {
  unsigned char* ws = p.ws;
  bf16* H = reinterpret_cast<bf16*>(ws + O_H);
  bf16* PROJ = reinterpret_cast<bf16*>(ws + O_PROJ);
  float* Y = reinterpret_cast<float*>(ws + O_Y);
  bf16* MRG = reinterpret_cast<bf16*>(ws + O_MRG);
  const int G = gridDim.x;
  const int wv_ = __builtin_amdgcn_readfirstlane(opaque_tid() >> 6);
  if (ph == 0) { if (EMASK & 0x2000) { mod_phase(p); __syncthreads(); conv_phase(p, 0, blockIdx.x, G, 0); } return; }
  if (ph == 1) { if (EMASK & 0x4000) e_phase(p, 0, 0, 0, T, blockIdx.x * 8 + wv_, G * 8, false); return; }
  const int l = (ph - 2) / 13, k = (ph - 2) % 13;
  const bool last = (l == 3);
  unsigned char* wsl = ws + (size_t)(l & 1) * WSZ;
  const bf16* WFI = reinterpret_cast<const bf16*>(wsl + O_WFI);
  const bf16* WFO = reinterpret_cast<const bf16*>(wsl + O_WFO);
  const bf16* WBR = reinterpret_cast<const bf16*>(wsl + O_WBR);
  const bf16* WOUT = reinterpret_cast<const bf16*>(wsl + O_WOUT);
  unsigned* flags = reinterpret_cast<unsigned*>(ws + O_BAR) + 3584 + l * 32;
  if (!((EMASK >> k) & 1)) return;
  switch (k) {
    case 0: case 10: {
      const int j = (k == 0) ? 0 : 1;
      const int M = (last && j == 1) ? TL : T;
      gemm_phase(j == 0 ? H : reinterpret_cast<const bf16*>(ws + O_H2), 1024, WFI + (size_t)j * 5632 * 1024, 1024, M, 5632, 1024, EpiSwiglu{PROJ});
      if (!last) {
        const int ntile = (M / 256) * 22, rem = ntile % G;
        if (rem != 0 && vblock() >= rem) { __syncthreads(); conv_phase(p, l + 1, vblock() - rem, G - rem, j == 0 ? 1 : 2); }
      }
    } break;
    case 1: case 11: {
      const int j = (k == 1) ? 0 : 1;
      gemm_phase(PROJ, 2816, WFO + (size_t)j * 1024 * 2816, 2816, TL, 1024, 2816, EpiF32{reinterpret_cast<bf16*>(Y)});
    } break;
    case 3: {
      const bf16* WIN = reinterpret_cast<const bf16*>(wsl + O_WIN);
      if (!last) gemm_phase(H, 1024, WIN, 1024, T, INP, 1024, EpiBf16{PROJ});
      else {
        EpiBf16 e{PROJ};
        for (int t = vblock(); t < 64 * 23 + 8 * 3; t += G) {
          int pm, pn;
          if (t < 64 * 23) tile_of(t, 64, 23, pm, pn); else { pm = 64 + (t - 64 * 23) / 3; pn = (t - 64 * 23) % 3; }
          gemm_tile(H, 1024, WIN, 1024, 1024, pm * 256, pn * 256, e);
        }
      }
    } break;
    case 4: break;
    case 5: m2_phase(p, l); break;
    case 6: break;
    case 7: {
      const int nM = TL / 256, nN = 4, ntile = nM * nN;
      for (int t = vblock(); t < ntile; t += G) {
        int pm, pn; tile_of(t, nM, nN, pm, pn);
        EpiBranch e{PROJ, MRG};
        gemm_tile_nb<EpiBranch, 4>(H, 256, (long)T * 256, WBR, 256, (long)1024 * 256, 256, pm * 256, pn * 256, e);
      }
    } break;
    case 8: gemm_phase(MRG, 1024, WOUT, 1024, TL, 1024, 1024, EpiF32{reinterpret_cast<bf16*>(Y)}); break;
    case 2: case 9: case 12: {
      const int mode = (k == 2) ? 1 : (k == 9) ? 2 : 3;
      const bool ctxwork = !(last && mode >= 2);
      if (ctxwork && blockIdx.x < 64) {
        const int c = blockIdx.x, pmc = 64 + (c >> 3), nt = (c >> 1) & 3, kh = c & 1;
        unsigned* fl = flags + (mode - 1) * 8 + (pmc - 64);
        float* Yc = reinterpret_cast<float*>(ws + O_Y + 37748736) + (size_t)kh * 2048 * 1024;
        EpiF32c ec{Yc};
        if (mode == 2) {
          unsigned* fla = flags + 24 + (pmc - 64);
          if (kh == 0) {
            EpiBranch e{PROJ, MRG};
            gemm_tile_nb<EpiBranch, 4>(H, 256, (long)T * 256, WBR, 256, (long)1024 * 256, 256, pmc * 256, nt * 256, e);
            flag_arrive(fla);
          }
          flag_wait(fla, 4u);
          gemm_tile(MRG + kh * 512, 1024, WOUT + kh * 512, 1024, 512, pmc * 256, nt * 256, ec);
        } else {
          const int j2 = (mode == 1) ? 0 : 1;
          gemm_tile(PROJ + kh * 1408, 2816, WFO + (size_t)j2 * 1024 * 2816 + kh * 1408, 2816, 1408, pmc * 256, nt * 256, ec);
        }
        flag_arrive(fl);
      } else if (ctxwork) {
        e_phase(p, l, mode, 0, TL, (blockIdx.x - 64) * 8 + wv_, (G - 64) * 8, false);
        const int lb = blockIdx.x - 64, nw = (G - 64) * 8;
        for (int base = lb * 8; base < 2048; base += nw) {
          flag_wait(flags + (mode - 1) * 8 + (base >> 8), 8u);
          e_phase(p, l, mode, TL + base, TL + base + 8, wv_, 8, true);
        }
      } else {
        e_phase(p, l, mode, 0, TL, blockIdx.x * 8 + wv_, G * 8, false);
      }

    } break;
  }
}

__global__ void __launch_bounds__(512, 2) fwd_kernel(Params p) {
  extern __shared__ __attribute__((aligned(16))) unsigned char smem[];
  volatile LAS unsigned* stw = (volatile LAS unsigned*)(smem + 131072);
  if (threadIdx.x < 4) stw[threadIdx.x] = 0u;
  __syncthreads();
  XcdBarrier bar = xcd_barrier_post(reinterpret_cast<unsigned*>(p.ws + O_BAR), stw);
  for (int ph = p.lo; ph < p.hi; ++ph) {
    if (ph >= 2 && ((ph - 2) % 13 == 6 || (ph - 2) % 13 == 4)) continue;
    run_phase(p, ph);
    if (ph + 1 < p.hi) {
      if (p.lo < 0) cg::this_grid().sync();
      xcd_barrier(bar);
    }
  }
}

extern "C" void kernel_launch(void* const* d_in, const int* in_sizes, int n_in, void* d_out, int out_size, void* d_ws, size_t ws_size, hipStream_t stream) {
  static int grid = 0;
  if (grid == 0) {
    if (n_in != 31 || ws_size < O_END) { fprintf(stderr, "kernel_launch: unexpected inputs (n_in %d, ws %zu < %zu)\n", n_in, ws_size, (size_t)O_END); grid = -1; return; }
    if (hipFuncSetAttribute((const void*)fwd_kernel, hipFuncAttributeMaxDynamicSharedMemorySize, LDS_BYTES) != hipSuccess) { fprintf(stderr, "hipFuncSetAttribute failed\n"); grid = -1; return; }
    int dev = 0, cus = 0, per_cu = 0;
    hipGetDevice(&dev);
    hipDeviceGetAttribute(&cus, hipDeviceAttributeMultiprocessorCount, dev);
    hipOccupancyMaxActiveBlocksPerMultiprocessor(&per_cu, (const void*)fwd_kernel, 512, LDS_BYTES);
    if (per_cu < 1) { fprintf(stderr, "occupancy query returned %d\n", per_cu); per_cu = 1; }
    grid = cus * 1;
    (void)hipGetLastError();
  }
  if (grid < 0) return;
  (void)hipMemsetAsync((unsigned char*)d_ws + O_BAR, 0, 16384, stream);
  Params p{};
  for (int i = 0; i < 31; ++i) p.in[i] = (const float*)d_in[i];
  p.out = (float*)d_out; p.ws = (unsigned char*)d_ws;
#if COOP
  p.lo = 0; p.hi = NPHASE;
  void* args[] = {&p};
  hipError_t e = hipLaunchCooperativeKernel((const void*)fwd_kernel, dim3(grid), dim3(512), args, LDS_BYTES, stream);
  if (e != hipSuccess) fprintf(stderr, "cooperative launch failed: %s (grid %d)\n", hipGetErrorString(e), grid);
#else
  for (int ph = 0; ph < NPHASE; ++ph) {
    p.lo = ph; p.hi = ph + 1;
    hipLaunchKernelGGL(fwd_kernel, dim3(grid), dim3(512), LDS_BYTES, stream, p);
  }
#endif
}
```

```cpp
#include <hip/hip_runtime.h>
#include <hip/hip_bf16.h>
#include <hip/hip_cooperative_groups.h>
#include <cstdio>
namespace cg = cooperative_groups;

#ifndef EMASK
#define EMASK 0x7fff
#endif
#ifndef DBLMASK
#define DBLMASK 0
#endif
#ifndef XSYNC
#define XSYNC 0
#endif
#ifndef COOP
#define COOP 1
#endif

using bf16 = __hip_bfloat16;
typedef short bf16x8 __attribute__((ext_vector_type(8)));
typedef float f32x4 __attribute__((ext_vector_type(4)));
typedef unsigned short us4 __attribute__((ext_vector_type(4)));
#define DEV __device__ __forceinline__

constexpr int T = 18432, TL = 16384, INP = 5888, NKEY = 2304;
constexpr int C_KVL = 0, C_KPE = 128, C_GK = 160, C_GV = 288, C_U = 416, C_QL = 672, C_GQ = 928, C_Z = 1184, C_GATE = 1696;
constexpr int LDS_BYTES = 131072 + 64;

constexpr size_t O_WFI = 0;
constexpr size_t O_WFO = O_WFI + 23068672;
constexpr size_t O_WIN = O_WFO + 11534336;
constexpr size_t O_WBR = O_WIN + 12058624;
constexpr size_t O_WOUT = O_WBR + 2097152;
constexpr size_t O_WUQ = O_WOUT + 2097152;
constexpr size_t O_WUKV = O_WUQ + 196608;
constexpr size_t O_WGLU = O_WUKV + 131072;
constexpr size_t O_WSP = O_WGLU + 262144;
constexpr size_t WSZ = O_WSP + 131072;
constexpr size_t O_MOD = 2 * WSZ;
constexpr size_t O_X = O_MOD + 1327104;
constexpr size_t O_H = O_X + 75497472;
constexpr size_t O_PROJ = O_H + 37748736;
constexpr size_t O_Y = O_PROJ + 217055232;
constexpr size_t O_MRG = O_Y + 75497472;
constexpr size_t O_GQ = O_MRG + 37748736;
constexpr size_t O_GK = O_GQ + 9437184;
constexpr size_t O_GVT = O_GK + 4718592;
constexpr size_t O_BAR = O_GVT + 4718592;
constexpr size_t O_H2 = O_BAR + 16384;
constexpr size_t O_END = O_H2 + 37748736;
constexpr size_t O_KMLA = O_MRG, O_VTMLA = O_MRG + 14155776, O_QMLA = O_VTMLA + 9437184;

struct Params {
  const float* in[31];
  float* out;
  unsigned char* ws;
  int lo, hi;
};

typedef __bf16 bf2_t __attribute__((ext_vector_type(2)));
typedef float f2_t __attribute__((ext_vector_type(2)));
typedef unsigned u32x2 __attribute__((ext_vector_type(2)));
typedef unsigned u32x4 __attribute__((ext_vector_type(4)));
DEV unsigned pk2(float a, float b) { f2_t v = {a, b}; bf2_t r = __builtin_convertvector(v, bf2_t); return *reinterpret_cast<unsigned*>(&r); }
DEV unsigned short f2bf(float f) { return (unsigned short)(pk2(f, 0.f) & 0xffffu); }
DEV bf16x8 pack8(float a0, float a1, float a2, float a3, float a4, float a5, float a6, float a7) {
  u32x4 r = {pk2(a0, a1), pk2(a2, a3), pk2(a4, a5), pk2(a6, a7)}; return *reinterpret_cast<bf16x8*>(&r); }
DEV float bf2f(unsigned short h) { return __uint_as_float(((unsigned)h) << 16); }
DEV float bfs2f(short h) { return __uint_as_float(((unsigned)(unsigned short)h) << 16); }
DEV u32x2 pack4(float a, float b, float c, float d) { u32x2 r = {pk2(a, b), pk2(c, d)}; return r; }
DEV bf16x8 ldg8(const bf16* p) { return *reinterpret_cast<const bf16x8*>(p); }
DEV us4 ldg4(const bf16* p) { return *reinterpret_cast<const us4*>(p); }
DEV void stg4(bf16* p, u32x2 v) { *reinterpret_cast<u32x2*>(p) = v; }
DEV float shx(float v, int mask, int lane) { return __int_as_float(__builtin_amdgcn_ds_bpermute((lane ^ mask) << 2, __float_as_int(v))); }
DEV float max_x16_x32(float v) {
  unsigned u = __float_as_uint(v);
  auto r = __builtin_amdgcn_permlane32_swap(u, u, false, false);
  float m = fmaxf(__uint_as_float(r[0]), __uint_as_float(r[1]));
  u = __float_as_uint(m);
  auto r2 = __builtin_amdgcn_permlane16_swap(u, u, false, false);
  return fmaxf(__uint_as_float(r2[0]), __uint_as_float(r2[1]));
}
DEV float sum_x16_x32(float v) {
  unsigned u = __float_as_uint(v);
  auto r = __builtin_amdgcn_permlane32_swap(u, u, false, false);
  float m = __uint_as_float(r[0]) + __uint_as_float(r[1]);
  u = __float_as_uint(m);
  auto r2 = __builtin_amdgcn_permlane16_swap(u, u, false, false);
  return __uint_as_float(r2[0]) + __uint_as_float(r2[1]);
}
DEV float dpp_(float v, int ctrl_b1, int which) {
  (void)ctrl_b1;
  const int x = __float_as_int(v);
  int r;
  if (which == 0) r = __builtin_amdgcn_update_dpp(x, x, 0xB1, 0xF, 0xF, false);
  else if (which == 1) r = __builtin_amdgcn_update_dpp(x, x, 0x4E, 0xF, 0xF, false);
  else if (which == 2) r = __builtin_amdgcn_update_dpp(x, x, 0x141, 0xF, 0xF, false);
  else r = __builtin_amdgcn_update_dpp(x, x, 0x140, 0xF, 0xF, false);
  return __int_as_float(r);
}
DEV float sum8_(float v) { v += dpp_(v, 0, 0); v += dpp_(v, 0, 1); v += dpp_(v, 0, 2); return v; }
DEV float wave_sum(float v, int lane) {
  (void)lane;
  v = sum8_(v); v += dpp_(v, 0, 3);
  return sum_x16_x32(v); }
DEV float rcp_(float x) { return __builtin_amdgcn_rcpf(x); }
DEV float sigmoidf_(float x) { return rcp_(1.f + __expf(-x)); }
DEV float siluf_(float x) { return x * rcp_(1.f + __expf(-x)); }
DEV float geluf_(float x) { float u = 0.7978845608028654f * (x + 0.044715f * x * x * x); float e = __expf(2.f * u); return x * (1.f - rcp_(1.f + e)); }
DEV int opaque_tid() { int t; asm volatile("v_mov_b32 %0, %1" : "=v"(t) : "v"((int)threadIdx.x)); return t; }
DEV f32x4 mfma16(bf16x8 a, bf16x8 b, f32x4 c) { return __builtin_amdgcn_mfma_f32_16x16x32_bf16(a, b, c, 0, 0, 0); }

DEV void sincos_acc(float x, float& s, float& c) {
  float kf = rintf(x * 0.636619772367581f);
  int k = (int)kf;
  float r = fmaf(-kf, 1.5703125f, x);
  r = fmaf(-kf, 4.837512969970703125e-4f, r);
  r = fmaf(-kf, 7.54978995489188216e-8f, r);
  float r2 = r * r;
  float sp = r + r * r2 * (-1.6666667163e-01f + r2 * (8.3333337680e-03f + r2 * (-1.9841270114e-04f + r2 * 2.7557314297e-06f)));
  float cp = 1.0f + r2 * (-0.5f + r2 * (4.1666667908e-02f + r2 * (-1.3888889225e-03f + r2 * 2.4801587642e-05f)));
  int q = k & 3;
  s = (q == 0) ? sp : (q == 1) ? cp : (q == 2) ? -sp : -cp;
  c = (q == 0) ? cp : (q == 1) ? -sp : (q == 2) ? -cp : sp;
}
DEV float rope1(float x, float xp, bool is_x2, float pos, int fi, float nf) {
  float freq = __builtin_amdgcn_exp2f(-13.287712379549449f * (float)fi / nf);
  float s, c; sincos_acc(pos * freq, s, c);
  return is_x2 ? x * c + xp * s : x * c - xp * s;
}

DEV int lds_byte(int r, int c) {
  int st = (r >> 4) * 2 + (c >> 5), rr = r & 15, cc = c & 31, ob = rr * 64 + cc * 2;
  return st * 1024 + (ob ^ (((ob >> 9) & 1) << 5));
}
DEV void stage_rc(int b, int& R, int& C) {
  int st = b / 1024, sb = b % 1024, swz = sb ^ (((sb >> 9) & 1) << 5);
  R = (st >> 1) * 16 + swz / 64; C = (st & 1) * 32 + (swz % 64) / 2;
}

template <class Epi, int NB>
DEV void gemm_tile_nb(const bf16* __restrict__ A, int lda, long strideA, const bf16* __restrict__ Bt, int ldb, long strideB, int K, int brow, int bcol, Epi& epi) {
  const int tidx_ = opaque_tid();
  extern __shared__ __attribute__((aligned(16))) unsigned char smem[];
  bf16* shm = reinterpret_cast<bf16*>(smem);
  constexpr int BK = 64, HALF = 128, HT = HALF * BK;
#define SA(b, h) (shm + ((b) * 2 + (h)) * HT)
#define SB(b, h) (shm + (4 + (b) * 2 + (h)) * HT)
#define STAGE(P, BASE, LD, br, kt) do { const bf16* _gb = BASE + ((long)(br) * (LD) + (long)(kt) * BK); \
    _Pragma("unroll") for (int _i = 0; _i < 2; ++_i) { \
      __builtin_amdgcn_global_load_lds((const unsigned*)(_gb + ((&LD == &lda) ? offA[_i] : offB[_i])), \
        (unsigned*)((char*)(P) + tidx_ * 16 + _i * 8192), 16, 0, 0); } } while (0)
#define LDA(dst, b, h) _Pragma("unroll") for (int m = 0; m < 4; ++m) _Pragma("unroll") for (int k = 0; k < 2; ++k) \
    dst[m][k] = *reinterpret_cast<const bf16x8*>(smem + (((b) * 2 + (h)) * 16384 + m * 2048 + k * 1024) + aoff)
#define LDB(dst, b, h) _Pragma("unroll") for (int n = 0; n < 2; ++n) _Pragma("unroll") for (int k = 0; k < 2; ++k) \
    dst[n][k] = *reinterpret_cast<const bf16x8*>(smem + (((b) * 2 + (h)) * 16384 + n * 2048 + k * 1024) + boff)
#define MMA(ai, bj, At_, Bt_) do { __builtin_amdgcn_s_setprio(1); \
    _Pragma("unroll") for (int m = 0; m < 4; ++m) _Pragma("unroll") for (int n = 0; n < 2; ++n) _Pragma("unroll") for (int k = 0; k < 2; ++k) \
      acc[ai][bj][m][n] = __builtin_amdgcn_mfma_f32_16x16x32_bf16(Bt_[n][k], At_[m][k], acc[ai][bj][m][n], 0, 0, 0); \
    __builtin_amdgcn_s_setprio(0); } while (0)
#define WAIT_V(n) asm volatile("s_waitcnt vmcnt(" #n ")" ::: "memory")
#define WAIT_L(n) asm volatile("s_waitcnt lgkmcnt(" #n ")" ::: "memory")
#define BAR __builtin_amdgcn_s_barrier()
#define SCHED __builtin_amdgcn_sched_barrier(0)
  const int wid = __builtin_amdgcn_readfirstlane(tidx_ >> 6), lane = tidx_ & 63, wr = wid >> 2, wc = wid & 3, fr = lane & 15, fq = lane >> 4;
  f32x4 acc[2][2][4][2] = {};
  bf16x8 At[4][2], B0[2][2], B1[2][2];
  const int nt = K / BK;
  const int lane_off_ = (fr * 64 + fq * 16) ^ ((fr >> 3) << 5);
  const int aoff = wr * 8192 + lane_off_, boff = 65536 + wc * 4096 + lane_off_;
  unsigned offA[2], offB[2];
#pragma unroll
  for (int _i = 0; _i < 2; ++_i) { int _r, _c; stage_rc(tidx_ * 16 + _i * 8192, _r, _c); offA[_i] = (unsigned)(_r * lda + _c); offB[_i] = (unsigned)(_r * ldb + _c); }
#pragma unroll 1
  for (int br = 0; br < NB; ++br) {
  STAGE(SB(0, 0), Bt, ldb, bcol, 0); STAGE(SA(0, 0), A, lda, brow, 0);
  STAGE(SB(0, 1), Bt, ldb, bcol + HALF, 0); STAGE(SA(0, 1), A, lda, brow + HALF, 0);
  if (wr == 1) BAR;
  WAIT_V(4); BAR;
  STAGE(SB(1, 0), Bt, ldb, bcol, 1); STAGE(SA(1, 0), A, lda, brow, 1); STAGE(SB(1, 1), Bt, ldb, bcol + HALF, 1);
  WAIT_V(6); BAR;
  for (int t = 0; t < nt - 2; t += 2) {
    LDB(B0, 0, 0); SCHED; LDA(At, 0, 0); STAGE(SA(1, 1), A, lda, brow + HALF, t + 1);
    WAIT_L(8); BAR; WAIT_L(0); MMA(0, 0, At, B0); BAR; SCHED;
    LDB(B1, 0, 1); STAGE(SB(0, 0), Bt, ldb, bcol, t + 2);
    BAR; WAIT_L(0); MMA(0, 1, At, B1); BAR;
    LDA(At, 0, 1); STAGE(SA(0, 0), A, lda, brow, t + 2);
    BAR; WAIT_L(0); MMA(1, 0, At, B0); BAR; SCHED;
    STAGE(SB(0, 1), Bt, ldb, bcol + HALF, t + 2);
    WAIT_V(6); BAR; MMA(1, 1, At, B1); BAR;
    LDB(B0, 1, 0); SCHED; LDA(At, 1, 0); STAGE(SA(0, 1), A, lda, brow + HALF, t + 2);
    WAIT_L(8); BAR; WAIT_L(0); MMA(0, 0, At, B0); BAR; SCHED;
    LDB(B1, 1, 1); STAGE(SB(1, 0), Bt, ldb, bcol, t + 3);
    BAR; WAIT_L(0); MMA(0, 1, At, B1); BAR;
    LDA(At, 1, 1); STAGE(SA(1, 0), A, lda, brow, t + 3);
    BAR; WAIT_L(0); MMA(1, 0, At, B0); BAR; SCHED;
    STAGE(SB(1, 1), Bt, ldb, bcol + HALF, t + 3);
    WAIT_V(6); BAR; MMA(1, 1, At, B1); BAR;
  }
  { LDB(B0, 0, 0); LDA(At, 0, 0); STAGE(SA(1, 1), A, lda, brow + HALF, nt - 1);
    BAR; WAIT_L(0); MMA(0, 0, At, B0); BAR;
    LDB(B1, 0, 1); BAR; WAIT_L(0); MMA(0, 1, At, B1); BAR;
    LDA(At, 0, 1); WAIT_V(4); BAR; WAIT_L(0); MMA(1, 0, At, B0); MMA(1, 1, At, B1); BAR; }
  { LDB(B0, 1, 0); LDA(At, 1, 0); WAIT_V(2); BAR; WAIT_L(0); MMA(0, 0, At, B0); BAR;
    LDB(B1, 1, 1); WAIT_V(0); BAR; WAIT_L(0); MMA(0, 1, At, B1); BAR;
    LDA(At, 1, 1); BAR; WAIT_L(0); MMA(1, 0, At, B0); MMA(1, 1, At, B1); BAR; }
  if (wr == 0) BAR;
  if constexpr (NB > 1) {
    if (br + 1 < NB) {
#pragma unroll
      for (int ai = 0; ai < 2; ++ai)
#pragma unroll
        for (int bj = 0; bj < 2; ++bj)
          { epi.mid(brow + ai * HALF + wr * 64 + fr, bcol + bj * HALF + wc * 32, fq, acc[ai][bj], br); __builtin_amdgcn_sched_barrier(0); }
    }
    A += strideA; Bt += strideB;
  }
  }
  if constexpr (Epi::PAIR) {
#pragma unroll
    for (int ai = 0; ai < 2; ++ai)
      { epi.pair(brow + ai * HALF + wr * 64 + fr, (bcol >> 1) + wc * 32, fq, acc[ai][0], acc[ai][1]); __builtin_amdgcn_sched_barrier(0); }
  } else {
#pragma unroll
  for (int ai = 0; ai < 2; ++ai)
#pragma unroll
    for (int bj = 0; bj < 2; ++bj)
      { epi.quad(brow + ai * HALF + wr * 64 + fr, bcol + bj * HALF + wc * 32, fq, acc[ai][bj]); __builtin_amdgcn_sched_barrier(0); }
  }
#undef SA
#undef SB
#undef STAGE
#undef LDA
#undef LDB
#undef MMA
}

template <class Epi>
DEV void gemm_tile(const bf16* __restrict__ A, int lda, const bf16* __restrict__ Bt, int ldb, int K, int brow, int bcol, Epi& epi) {
  gemm_tile_nb<Epi, 1>(A, lda, 0, Bt, ldb, 0, K, brow, bcol, epi);
}

DEV int vblock() { const int G = gridDim.x, bx = blockIdx.x; return (G % 8 == 0) ? (bx % 8) * (G / 8) + bx / 8 : bx; }

DEV void tile_of(int t, int nM, int nN, int& pm, int& pn) {
  int nig = 8 * nN, gid = t / nig, fm = gid * 8, gsz = min(nM - fm, 8);
  pm = fm + (t % nig) % gsz; pn = (t % nig) / gsz;
}

template <class Epi>
DEV void gemm_phase(const bf16* A, int lda, const bf16* Bt, int ldb, int M, int N, int K, Epi epi) {
  const int nM = M / 256, nN = N / 256, ntile = nM * nN;
  for (int t = vblock(); t < ntile; t += gridDim.x) {
    int pm, pn; tile_of(t, nM, nN, pm, pn);
    gemm_tile(A, lda, Bt, ldb, K, pm * 256, pn * 256, epi);
  }
}

struct EpiSwiglu {
  bf16* h1;
  static constexpr bool PAIR = true;
  DEV void pair(int row0, int hcol, int fq, f32x4 (&a)[4][2], f32x4 (&g)[4][2]) const {
#pragma unroll
    for (int m = 0; m < 4; ++m) {
      float v[8];
#pragma unroll
      for (int n = 0; n < 2; ++n)
#pragma unroll
        for (int r = 0; r < 4; ++r) v[n * 4 + r] = siluf_(a[m][n][r]) * g[m][n][r];
      *reinterpret_cast<bf16x8*>(h1 + (size_t)(row0 + m * 16) * 2816 + hcol + fq * 8) = pack8(v[0], v[1], v[2], v[3], v[4], v[5], v[6], v[7]);
      __builtin_amdgcn_sched_barrier(0);
    }
  }
  DEV void quad(int, int, int, f32x4 (&)[4][2]) const {}
};
struct EpiF32 {
  static constexpr bool PAIR = false;
  bf16* out; static constexpr int ld = 1024;
  DEV void operator()(int row, int colbase, int fq, f32x4 a0, f32x4 a1) const {
    bf16* p = out + (size_t)row * ld + colbase + fq * 8;
    *reinterpret_cast<bf16x8*>(p) = pack8(a0[0], a0[1], a0[2], a0[3], a1[0], a1[1], a1[2], a1[3]);
  }
  DEV void quad(int row0, int colbase, int fq, f32x4 (&a)[4][2]) const {
#pragma unroll
    for (int m = 0; m < 4; ++m) { (*this)(row0 + m * 16, colbase, fq, a[m][0], a[m][1]); __builtin_amdgcn_sched_barrier(0); }
  }
};
struct EpiF32c {
  static constexpr bool PAIR = false;
  float* out;
  DEV void operator()(int row, int colbase, int fq, f32x4 a0, f32x4 a1) const {
    float* p = out + (size_t)(row - TL) * 1024 + colbase + fq * 8;
    *reinterpret_cast<f32x4*>(p) = a0; *reinterpret_cast<f32x4*>(p + 4) = a1;
  }
  DEV void quad(int row0, int colbase, int fq, f32x4 (&a)[4][2]) const {
#pragma unroll
    for (int m = 0; m < 4; ++m) { (*this)(row0 + m * 16, colbase, fq, a[m][0], a[m][1]); __builtin_amdgcn_sched_barrier(0); }
  }
};
struct EpiBf16 {
  static constexpr bool PAIR = false;
  bf16* out; static constexpr int ld = INP;
  DEV void operator()(int row, int colbase, int fq, f32x4 a0, f32x4 a1) const {
    bf16* p = out + (size_t)row * ld + colbase + fq * 8;
    *reinterpret_cast<bf16x8*>(p) = pack8(a0[0], a0[1], a0[2], a0[3], a1[0], a1[1], a1[2], a1[3]);
  }
  DEV void quad(int row0, int colbase, int fq, f32x4 (&a)[4][2]) const {
#pragma unroll
    for (int m = 0; m < 4; ++m) { (*this)(row0 + m * 16, colbase, fq, a[m][0], a[m][1]); __builtin_amdgcn_sched_barrier(0); }
  }
};
struct EpiBranch {
  static constexpr bool PAIR = false;
  const bf16* proj; bf16* merged;
  DEV void mid(int row0, int colbase, int fq, f32x4 (&a)[4][2], int br) const {
    asm volatile("" : "+v"(row0), "+v"(fq));
    bf16x8 ga[4], gb[4];
    const bf16* gp = proj + C_GATE + br * 1024 + colbase + fq * 8;
#pragma unroll
    for (int m = 0; m < 4; ++m) { const size_t row = row0 + m * 16; ga[m] = ldg8(gp + row * INP); gb[m] = ldg8(gp + row * INP + 1024); }
#pragma unroll
    for (int m = 0; m < 4; ++m)
#pragma unroll
      for (int n = 0; n < 2; ++n)
#pragma unroll
        for (int r = 0; r < 4; ++r) a[m][n][r] *= (1.f + __expf(-bfs2f(gb[m][n * 4 + r]))) * rcp_(1.f + __expf(-bfs2f(ga[m][n * 4 + r])));
  }
  DEV void quad(int row0, int colbase, int fq, f32x4 (&a)[4][2]) const {
    asm volatile("" : "+v"(row0), "+v"(fq));
    bf16x8 ga[4];
    const bf16* gp = proj + C_GATE + 3 * 1024 + colbase + fq * 8;
#pragma unroll
    for (int m = 0; m < 4; ++m) ga[m] = ldg8(gp + (size_t)(row0 + m * 16) * INP);
#pragma unroll
    for (int m = 0; m < 4; ++m) {
      float v[8];
#pragma unroll
      for (int n = 0; n < 2; ++n)
#pragma unroll
        for (int r = 0; r < 4; ++r) v[n * 4 + r] = a[m][n][r] * rcp_(1.f + __expf(-bfs2f(ga[m][n * 4 + r])));
      *reinterpret_cast<bf16x8*>(merged + (size_t)(row0 + m * 16) * 1024 + colbase + fq * 8) = pack8(v[0], v[1], v[2], v[3], v[4], v[5], v[6], v[7]);
    }
  }
};

DEV void mod_phase(const Params& p) {
  const int tidx_ = opaque_tid();
  extern __shared__ __attribute__((aligned(16))) unsigned char smem[];
  float* sl = reinterpret_cast<float*>(smem);
  float* part = sl + 9 * 1024;
  const int tid = tidx_;
  const float* c = p.in[1]; const float* cc = p.in[3]; const float* w_ada = p.in[4]; const float* b_ada = p.in[5];
  float* MOD = reinterpret_cast<float*>(p.ws + O_MOD);
  for (int i = tid; i < 9 * 1024; i += 512) { int r = i >> 10, k = i & 1023; float v = r < 8 ? c[r * 1024 + k] : cc[k]; sl[i] = v / (1.f + __expf(-v)); }
  __syncthreads();
  for (int item = blockIdx.x; item < 576; item += gridDim.x) {
    const int l = item / 144, n0 = (item % 144) * 64;
    const int cq = tid & 15, kg = tid >> 4;
    const float* w = w_ada + (size_t)l * 1024 * 9216 + n0 + cq * 4;
    float acc[9][4];
#pragma unroll
    for (int r = 0; r < 9; ++r) for (int e = 0; e < 4; ++e) acc[r][e] = 0.f;
#pragma unroll 4
    for (int kk = 0; kk < 32; ++kk) {
      const int k = kg * 32 + kk;
      f32x4 wv = *reinterpret_cast<const f32x4*>(w + (size_t)k * 9216);
#pragma unroll
      for (int r = 0; r < 9; ++r) { float s = sl[r * 1024 + k];
#pragma unroll
        for (int e = 0; e < 4; ++e) acc[r][e] = fmaf(s, wv[e], acc[r][e]); }
    }
#pragma unroll
    for (int r = 0; r < 9; ++r)
#pragma unroll
      for (int e = 0; e < 4; ++e) part[(kg * 9 + r) * 64 + cq * 4 + e] = acc[r][e];
    __syncthreads();
    for (int o = tid; o < 576; o += 512) {
      int r = o >> 6, col = o & 63; float s = 0.f;
      for (int g = 0; g < 32; ++g) s += part[(g * 9 + r) * 64 + col];
      MOD[(size_t)l * 9 * 9216 + (size_t)r * 9216 + n0 + col] = s + b_ada[l * 9216 + n0 + col];
    }
    __syncthreads();
  }
}

DEV void conv_T(const float* __restrict__ src, int K, int N, bf16* __restrict__ dst, int Npad, int mapmode, int rot, int vb, int nv) {
  const int tidx_ = opaque_tid();
  extern __shared__ __attribute__((aligned(16))) unsigned char smem[];
  float* tl = reinterpret_cast<float*>(smem);
  const int tid = tidx_, G = nv;
  const int nk = K / 64, nn = Npad / 64, ntiles = nk * nn;
  for (int tile = (vb + rot) % G; tile < ntiles; tile += G) {
    const int kt = tile % nk, ntile = tile / nk, k0 = kt * 64, n0 = ntile * 64;
#pragma unroll
    for (int i = 0; i < 8; ++i) { int idx = tid + i * 512, r = idx >> 6, cc = idx & 63, n = n0 + cc;
      tl[r * 65 + cc] = n < N ? __builtin_nontemporal_load(src + (size_t)(k0 + r) * N + n) : 0.f; }
    __syncthreads();
#pragma unroll
    for (int i = 0; i < 4; ++i) { int pidx = tid + i * 512, rn = pidx >> 5, ck = (pidx & 31) * 2, n = n0 + rn;
      int dr = n;
      if (mapmode == 1) { int j = n < 2816 ? n : n - 2816; int c = j & 127, a = c & 31;
        dr = (j >> 7) * 256 + (n < 2816 ? 0 : 128) + (c & ~31) + ((a >> 2) & 1) * 16 + (a >> 3) * 4 + (a & 3); }
      if (mapmode == 2) { int a = n & 31; dr = (n & ~31) + ((a >> 2) & 1) * 16 + (a >> 3) * 4 + (a & 3); }
      unsigned v = (unsigned)f2bf(tl[ck * 65 + rn]) | ((unsigned)f2bf(tl[(ck + 1) * 65 + rn]) << 16);
      __builtin_nontemporal_store(v, reinterpret_cast<unsigned*>(dst + (size_t)dr * K + k0 + ck)); }
    __syncthreads();
  }
}

DEV void conv_phase(const Params& p, int l, int vb, int nv, int part) {
  const int tidx_ = opaque_tid();
  unsigned char* ws = p.ws + (size_t)(l & 1) * WSZ;
  if (part != 2) {
    for (int j = 0; j < 2; ++j)
      conv_T(p.in[8] + (size_t)(l * 2 + j) * 1024 * 5632, 1024, 5632, reinterpret_cast<bf16*>(ws + O_WFI) + (size_t)j * 5632 * 1024, 5632, 1, j * 128, vb, nv);
  }
  if (part != 1) {
    for (int j = 0; j < 2; ++j)
      conv_T(p.in[9] + (size_t)(l * 2 + j) * 2816 * 1024, 2816, 1024, reinterpret_cast<bf16*>(ws + O_WFO) + (size_t)j * 1024 * 2816, 1024, 2, j * 192 + 64, vb, nv);
    conv_T(p.in[10] + (size_t)l * 1024 * 5792, 1024, 5792, reinterpret_cast<bf16*>(ws + O_WIN), 5888, 2, 192, vb, nv);
    for (int i = 0; i < 4; ++i)
      conv_T(p.in[29] + (size_t)(l * 4 + i) * 256 * 1024, 256, 1024, reinterpret_cast<bf16*>(ws + O_WBR) + (size_t)i * 1024 * 256, 1024, 2, i * 64, vb, nv);
    conv_T(p.in[30] + (size_t)l * 1024 * 1024, 1024, 1024, reinterpret_cast<bf16*>(ws + O_WOUT), 1024, 2, 0, vb, nv);
    conv_T(p.in[12] + (size_t)l * 256 * 384, 256, 384, reinterpret_cast<bf16*>(ws + O_WUQ), 384, 0, 0, vb, nv);
    conv_T(p.in[14] + (size_t)l * 128 * 512, 128, 512, reinterpret_cast<bf16*>(ws + O_WUKV), 512, 0, 24, vb, nv);
    conv_T(p.in[24] + (size_t)l * 256 * 512, 256, 512, reinterpret_cast<bf16*>(ws + O_WGLU), 512, 0, 40, vb, nv);
    { const float* src = p.in[27] + (size_t)l * 65536; bf16* dst = reinterpret_cast<bf16*>(ws + O_WSP);
      for (int i = vb * 512 + tidx_; i < 65536; i += nv * 512) reinterpret_cast<unsigned short*>(dst)[i] = f2bf(src[i]); }
  }
}

DEV void e_phase(const Params& p, int l, int mode, int t_begin, int t_end, int widx, int wcount, bool ctxsum) {
  const int tidx_ = opaque_tid();
  float* X = reinterpret_cast<float*>(p.ws + O_X);
  const bf16* Y = reinterpret_cast<const bf16*>(p.ws + O_Y);
  const float* YC = reinterpret_cast<const float*>(p.ws + O_Y + 37748736);
  bf16* H = reinterpret_cast<bf16*>(p.ws + (mode == 2 ? O_H2 : O_H));
  const float* MOD = reinterpret_cast<const float*>(p.ws + O_MOD);
  const float* npre = p.in[6]; const float* npost = p.in[7];
  const int lane = tidx_ & 63;
  const int sp = mode - 1; const float wgt = (sp == 1) ? 1.f : 0.5f;
  const int ln = (mode == 3) ? l + 1 : l; const int s = (mode == 3) ? 0 : mode;
  const bool final_out = (mode == 3 && l == 3);
  f32x4 xn[4], ya[4], yb[4]; us4 yh[4];
#define LOADROW(tt) do { const int t_ = (tt); \
    const float* xs_ = (mode == 0) ? (t_ < TL ? p.in[0] + (size_t)t_ * 1024 : p.in[2] + (size_t)(t_ - TL) * 1024) : X + (size_t)t_ * 1024; \
    _Pragma("unroll") for (int i = 0; i < 4; ++i) { const int c0 = i * 256 + lane * 4; \
      xn[i] = __builtin_nontemporal_load(reinterpret_cast<const f32x4*>(xs_ + c0)); \
      if (mode != 0) { if (ctxsum) { const float* yc_ = YC + (size_t)(t_ - TL) * 1024 + c0; ya[i] = *reinterpret_cast<const f32x4*>(yc_); yb[i] = *reinterpret_cast<const f32x4*>(yc_ + (size_t)2048 * 1024); } \
                       else yh[i] = ldg4(Y + (size_t)t_ * 1024 + c0); } } } while (0)
  const int rpw = (t_end - t_begin + wcount - 1) / wcount;
  int t = t_begin + widx * rpw;
  t_end = min(t_end, t + rpw);
  if (t < t_end) LOADROW(t);
  int cur_mi = -1;
  f32x4 gt[4], gg[4], g2[4], sh[4], sc[4];
  while (t < t_end) {
    const int mi = t < TL ? (t >> 11) : 8;
    if (mi != cur_mi) {
      cur_mi = mi;
      const float* gate = MOD + (size_t)l * 9 * 9216 + (size_t)mi * 9216 + (3 * sp + 2) * 1024;
      const float* gp = npost + (l * 3 + sp) * 1024;
      const float* gpre = npre + (ln * 3 + s) * 1024;
      const float* mrow = MOD + (size_t)ln * 9 * 9216 + (size_t)mi * 9216;
#pragma unroll
      for (int i = 0; i < 4; ++i) { const int c0 = i * 256 + lane * 4;
        if (mode != 0) { gt[i] = *reinterpret_cast<const f32x4*>(gate + c0); gg[i] = *reinterpret_cast<const f32x4*>(gp + c0); }
        if (!final_out) { g2[i] = *reinterpret_cast<const f32x4*>(gpre + c0);
          sh[i] = *reinterpret_cast<const f32x4*>(mrow + (3 * s) * 1024 + c0);
          sc[i] = *reinterpret_cast<const f32x4*>(mrow + (3 * s + 1) * 1024 + c0); } }
    }
    f32x4 xv[4], yv[4];
#pragma unroll
    for (int i = 0; i < 4; ++i) { xv[i] = xn[i];
      if (mode != 0) yv[i] = ctxsum ? (ya[i] + yb[i]) : (f32x4){bf2f(yh[i][0]), bf2f(yh[i][1]), bf2f(yh[i][2]), bf2f(yh[i][3])}; }
    const int tn = t + 1;
    if (tn < t_end) LOADROW(tn);
    if (mode == 0) {
#pragma unroll
      for (int i = 0; i < 4; ++i) *reinterpret_cast<f32x4*>(X + (size_t)t * 1024 + i * 256 + lane * 4) = xv[i];
    } else {
      float ss = 0.f;
#pragma unroll
      for (int i = 0; i < 4; ++i) ss += yv[i][0] * yv[i][0] + yv[i][1] * yv[i][1] + yv[i][2] * yv[i][2] + yv[i][3] * yv[i][3];
      ss = wave_sum(ss, lane);
      const float rstd = rsqrtf(ss * (1.f / 1024.f) + 1e-6f);
#pragma unroll
      for (int i = 0; i < 4; ++i) { const int c0 = i * 256 + lane * 4;
#pragma unroll
        for (int e = 0; e < 4; ++e) xv[i][e] += wgt * gt[i][e] * (yv[i][e] * rstd * gg[i][e]);
        if (!final_out) __builtin_nontemporal_store(xv[i], reinterpret_cast<f32x4*>(X + (size_t)t * 1024 + c0)); }
    }
    if (final_out) {
      if (t < TL) {
#pragma unroll
        for (int i = 0; i < 4; ++i) *reinterpret_cast<f32x4*>(p.out + (size_t)t * 1024 + i * 256 + lane * 4) = xv[i];
      }
    } else {
      float ss = 0.f;
#pragma unroll
      for (int i = 0; i < 4; ++i) ss += xv[i][0] * xv[i][0] + xv[i][1] * xv[i][1] + xv[i][2] * xv[i][2] + xv[i][3] * xv[i][3];
      ss = wave_sum(ss, lane);
      const float rstd = rsqrtf(ss * (1.f / 1024.f) + 1e-6f);
#pragma unroll
      for (int i = 0; i < 4; ++i) { const int c0 = i * 256 + lane * 4;
        float o[4];
#pragma unroll
        for (int e = 0; e < 4; ++e) o[e] = xv[i][e] * rstd * g2[i][e] * (1.f + sc[i][e]) + sh[i][e];
        __builtin_nontemporal_store(pack4(o[0], o[1], o[2], o[3]), reinterpret_cast<u32x2*>(H + (size_t)t * 1024 + c0)); }
    }
    t = tn;
  }
#undef LOADROW
}

template <int KS>
DEV void load_norm_frags(const bf16* rowptr, const float* gain, bf16x8 (&fr)[KS], int fq, int lane) {
  float v[KS][8]; float ss = 0.f;
#pragma unroll
  for (int kk = 0; kk < KS; ++kk) { bf16x8 raw = ldg8(rowptr + kk * 32 + fq * 8);
#pragma unroll
    for (int e = 0; e < 8; ++e) { v[kk][e] = bfs2f(raw[e]); ss += v[kk][e] * v[kk][e]; } }
  ss += shx(ss, 16, lane); ss += shx(ss, 32, lane);
  const float rstd = rsqrtf(ss * (1.f / (KS * 32)) + 1e-6f);
#pragma unroll
  for (int kk = 0; kk < KS; ++kk) { const float* gp = gain + kk * 32 + fq * 8;
    fr[kk] = pack8(v[kk][0] * rstd * gp[0], v[kk][1] * rstd * gp[1], v[kk][2] * rstd * gp[2], v[kk][3] * rstd * gp[3],
                   v[kk][4] * rstd * gp[4], v[kk][5] * rstd * gp[5], v[kk][6] * rstd * gp[6], v[kk][7] * rstd * gp[7]); }
}

DEV void m1_item(const Params& p, int l, int item) {
  extern __shared__ __attribute__((aligned(16))) unsigned char smem[];
  const int tidx_ = opaque_tid();
  unsigned char* ws = p.ws;
  const bf16* PROJ = reinterpret_cast<const bf16*>(ws + O_PROJ);
  bf16* KMLA = reinterpret_cast<bf16*>(ws + O_KMLA); bf16* VTMLA = reinterpret_cast<bf16*>(ws + O_VTMLA); bf16* QMLA = reinterpret_cast<bf16*>(ws + O_QMLA);
  bf16* GQ = reinterpret_cast<bf16*>(ws + O_GQ); bf16* GK = reinterpret_cast<bf16*>(ws + O_GK); bf16* GVT = reinterpret_cast<bf16*>(ws + O_GVT);
  const bf16* WUQ = reinterpret_cast<const bf16*>(ws + (size_t)(l & 1) * WSZ + O_WUQ); const bf16* WUKV = reinterpret_cast<const bf16*>(ws + (size_t)(l & 1) * WSZ + O_WUKV);
  const float* qn = p.in[11] + l * 256; const float* kvn = p.in[13] + l * 128;
  const int wv = __builtin_amdgcn_readfirstlane(tidx_ >> 6);
  constexpr int KVP = 136, QP = 264;
  unsigned short* Akv = reinterpret_cast<unsigned short*>(smem);
  unsigned short* Aq = reinterpret_cast<unsigned short*>(smem + 64 * KVP * 2);
  {
    const int lane = opaque_tid() & 63, fr = lane & 15, fq = lane >> 4;
    const int t0 = item * 64; const bool lat = t0 < TL;
    const int b = lat ? (t0 >> 11) : ((t0 - TL) >> 8);
    const int pos0 = lat ? (t0 & 2047) : 2048 + ((t0 - TL) & 255);
    {
      const int tk = (wv << 3) | (lane >> 3), part = lane & 7;
      const bf16* prow = PROJ + (size_t)(t0 + tk) * INP;
      float v[16]; float ss = 0.f;
#pragma unroll
      for (int q = 0; q < 2; ++q) { bf16x8 raw = ldg8(prow + C_KVL + part * 16 + q * 8);
#pragma unroll
        for (int e = 0; e < 8; ++e) { v[q * 8 + e] = bfs2f(raw[e]); ss += v[q * 8 + e] * v[q * 8 + e]; } }
      ss = sum8_(ss);
      float rstd = rsqrtf(ss * (1.f / 128.f) + 1e-6f);
#pragma unroll
      for (int q = 0; q < 2; ++q) { const float* gp = kvn + part * 16 + q * 8;
        *reinterpret_cast<bf16x8*>(Akv + tk * KVP + part * 16 + q * 8) =
          pack8(v[q * 8 + 0] * rstd * gp[0], v[q * 8 + 1] * rstd * gp[1], v[q * 8 + 2] * rstd * gp[2], v[q * 8 + 3] * rstd * gp[3],
                v[q * 8 + 4] * rstd * gp[4], v[q * 8 + 5] * rstd * gp[5], v[q * 8 + 6] * rstd * gp[6], v[q * 8 + 7] * rstd * gp[7]); }
      float w[32]; ss = 0.f;
#pragma unroll
      for (int q = 0; q < 4; ++q) { bf16x8 raw = ldg8(prow + C_QL + part * 32 + q * 8);
#pragma unroll
        for (int e = 0; e < 8; ++e) { w[q * 8 + e] = bfs2f(raw[e]); ss += w[q * 8 + e] * w[q * 8 + e]; } }
      ss = sum8_(ss);
      rstd = rsqrtf(ss * (1.f / 256.f) + 1e-6f);
#pragma unroll
      for (int q = 0; q < 4; ++q) { const float* gp = qn + part * 32 + q * 8;
        *reinterpret_cast<bf16x8*>(Aq + tk * QP + part * 32 + q * 8) =
          pack8(w[q * 8 + 0] * rstd * gp[0], w[q * 8 + 1] * rstd * gp[1], w[q * 8 + 2] * rstd * gp[2], w[q * 8 + 3] * rstd * gp[3],
                w[q * 8 + 4] * rstd * gp[4], w[q * 8 + 5] * rstd * gp[5], w[q * 8 + 6] * rstd * gp[6], w[q * 8 + 7] * rstd * gp[7]); }
    }
    __syncthreads();
    {
      const int h = wv >> 1, half = wv & 1;
      bf16x8 wf[4][4];
#pragma unroll
      for (int nt = 0; nt < 4; ++nt)
#pragma unroll
        for (int kk = 0; kk < 4; ++kk) wf[nt][kk] = ldg8(WUKV + (size_t)(h * 128 + half * 64 + nt * 16 + fr) * 128 + kk * 32 + fq * 8);
#pragma unroll 1
      for (int m = 0; m < 4; ++m) {
        bf16x8 af[4];
#pragma unroll
        for (int kk = 0; kk < 4; ++kk) af[kk] = *reinterpret_cast<const bf16x8*>(Akv + (m * 16 + fr) * KVP + kk * 32 + fq * 8);
#pragma unroll
        for (int nt = 0; nt < 4; ++nt) {
          f32x4 acc = {0.f, 0.f, 0.f, 0.f};
          if (half == 0) {
#pragma unroll
            for (int kk = 0; kk < 4; ++kk) acc = mfma16(wf[nt][kk], af[kk], acc);
            stg4(KMLA + ((size_t)(b * 4 + h) * NKEY + pos0 + m * 16 + fr) * 96 + nt * 16 + fq * 4, pack4(acc[0], acc[1], acc[2], acc[3]));
          } else {
#pragma unroll
            for (int kk = 0; kk < 4; ++kk) acc = mfma16(af[kk], wf[nt][kk], acc);
            stg4(VTMLA + ((size_t)(b * 4 + h) * 64 + nt * 16 + fr) * NKEY + pos0 + m * 16 + fq * 4, pack4(acc[0], acc[1], acc[2], acc[3]));
          }
        }
      }
    }
    {
      bf16x8 wq[3][8];
#pragma unroll
      for (int i = 0; i < 3; ++i)
#pragma unroll
        for (int kk = 0; kk < 8; ++kk) wq[i][kk] = ldg8(WUQ + (size_t)((wv * 3 + i) * 16 + fr) * 256 + kk * 32 + fq * 8);
#pragma unroll 1
      for (int m = 0; m < 4; ++m) {
        bf16x8 af[8];
#pragma unroll
        for (int kk = 0; kk < 8; ++kk) af[kk] = *reinterpret_cast<const bf16x8*>(Aq + (m * 16 + fr) * QP + kk * 32 + fq * 8);
#pragma unroll
        for (int i = 0; i < 3; ++i) {
          const int n = wv * 3 + i, within = n % 6;
          f32x4 acc = {0.f, 0.f, 0.f, 0.f};
#pragma unroll
          for (int kk = 0; kk < 8; ++kk) acc = mfma16(wq[i][kk], af[kk], acc);
          if (within >= 4 && lat) {
            const int pos = pos0 + m * 16 + fr; const float pa = (float)((within == 4) ? (pos >> 6) : (pos & 63));
            f32x4 o;
#pragma unroll
            for (int r = 0; r < 4; ++r) { float xp = shx(acc[r], 32, lane); o[r] = rope1(acc[r], xp, fq >= 2, pa, (fq & 1) * 4 + r, 8.f); }
            acc = o;
          }
          stg4(QMLA + (size_t)(t0 + m * 16 + fr) * 384 + n * 16 + fq * 4, pack4(acc[0], acc[1], acc[2], acc[3]));
        }
      }
    }
    {
      const int tt0 = t0 + (wv & 3) * 16, pp0 = pos0 + (wv & 3) * 16;
      if (wv < 4) {
        {
          const int tk = lane >> 2, part = lane & 3;
          const bf16* src = PROJ + (size_t)(tt0 + tk) * INP + C_KPE;
          bf16x8 raw = ldg8(src + part * 8), rawp = ldg8(src + (part ^ 1) * 8);
          bf16x8 o = raw;
          if (lat) {
            const int pos = pp0 + tk; const float pa = (float)((part < 2) ? (pos >> 6) : (pos & 63));
            float of_[8];
#pragma unroll
            for (int e = 0; e < 8; ++e) of_[e] = rope1(bfs2f(raw[e]), bfs2f(rawp[e]), (part & 1) != 0, pa, e, 8.f);
            o = pack8(of_[0], of_[1], of_[2], of_[3], of_[4], of_[5], of_[6], of_[7]);
          }
          for (int h = 0; h < 4; ++h)
            *reinterpret_cast<bf16x8*>(KMLA + ((size_t)(b * 4 + h) * NKEY + pp0 + tk) * 96 + 64 + part * 8) = o;
        }
        for (int it = 0; it < 8; ++it) {
          const int ci = lane + it * 64, tk = ci >> 5, c = ci & 31, head = c >> 3, cc = c & 7;
          const bf16* src = PROJ + (size_t)(tt0 + tk) * INP + C_GQ + head * 64;
          bf16x8 raw = ldg8(src + cc * 8), rawp = ldg8(src + (cc ^ 2) * 8), o = raw;
          if (lat) { const int pos = pp0 + tk; const float pa = (float)((cc < 4) ? (pos >> 6) : (pos & 63));
            float of_[8];
#pragma unroll
            for (int e = 0; e < 8; ++e) of_[e] = rope1(bfs2f(raw[e]), bfs2f(rawp[e]), (cc & 2) != 0, pa, (cc & 1) * 8 + e, 16.f);
            o = pack8(of_[0], of_[1], of_[2], of_[3], of_[4], of_[5], of_[6], of_[7]); }
          *reinterpret_cast<bf16x8*>(GQ + (size_t)(tt0 + tk) * 256 + head * 64 + cc * 8) = o;
        }
      } else {
        for (int it = 0; it < 4; ++it) {
          const int ci = lane + it * 64, tk = ci >> 4, c = ci & 15, kvh = c >> 3, cc = c & 7;
          const bf16* src = PROJ + (size_t)(tt0 + tk) * INP + C_GK + kvh * 64;
          bf16x8 raw = ldg8(src + cc * 8), rawp = ldg8(src + (cc ^ 2) * 8), o = raw;
          if (lat) { const int pos = pp0 + tk; const float pa = (float)((cc < 4) ? (pos >> 6) : (pos & 63));
            float of_[8];
#pragma unroll
            for (int e = 0; e < 8; ++e) of_[e] = rope1(bfs2f(raw[e]), bfs2f(rawp[e]), (cc & 2) != 0, pa, (cc & 1) * 8 + e, 16.f);
            o = pack8(of_[0], of_[1], of_[2], of_[3], of_[4], of_[5], of_[6], of_[7]); }
          *reinterpret_cast<bf16x8*>(GK + ((size_t)(b * 2 + kvh) * NKEY + pp0 + tk) * 64 + cc * 8) = o;
        }
        for (int it = 0; it < 2; ++it) {
          const int ch = lane + it * 64, kvh = ch >> 6, d = ch & 63;
          const unsigned short* src = reinterpret_cast<const unsigned short*>(PROJ) + (size_t)tt0 * INP + C_GV + ch;
          bf16x8 o0, o1;
#pragma unroll
          for (int k = 0; k < 8; ++k) { o0[k] = (short)src[(size_t)k * INP]; o1[k] = (short)src[(size_t)(k + 8) * INP]; }
          bf16* dst = GVT + ((size_t)(b * 2 + kvh) * 64 + d) * NKEY + pp0;
          *reinterpret_cast<bf16x8*>(dst) = o0; *reinterpret_cast<bf16x8*>(dst + 8) = o1;
        }
      }
    }
    __syncthreads();
  }
}

template <int KS>
DEV void attn_chunk(const unsigned char* Kl, const unsigned char* Vl, const bf16x8 (&qf)[2][KS], f32x4 (&O)[2][4], float (&mrun)[2], float (&lrun)[2],
                    bool masked, int key0, int qw0, float sl2, int lane, int fr, int fq) {
  constexpr int DK = KS * 32, KP = DK + 8, VP = 72;
  f32x4 sc[2][4];
#pragma unroll
  for (int kt = 0; kt < 4; ++kt) {
    sc[0][kt] = (f32x4){0.f, 0.f, 0.f, 0.f}; sc[1][kt] = (f32x4){0.f, 0.f, 0.f, 0.f};
#pragma unroll
    for (int kk = 0; kk < KS; ++kk) {
      bf16x8 kf = *reinterpret_cast<const bf16x8*>(Kl + ((kt * 16 + fr) * KP + kk * 32 + fq * 8) * 2);
      sc[0][kt] = mfma16(kf, qf[0][kk], sc[0][kt]); sc[1][kt] = mfma16(kf, qf[1][kk], sc[1][kt]);
    }
  }
  bf16x8 pf[2][2];
#pragma unroll
  for (int qi = 0; qi < 2; ++qi) {
    float mx = -1e30f;
#pragma unroll
    for (int kt = 0; kt < 4; ++kt)
#pragma unroll
      for (int r = 0; r < 4; ++r) { float v = sc[qi][kt][r] * sl2;
        if (masked) { int kp = key0 + kt * 16 + fq * 4 + r; int dq = qw0 + qi * 16 + fr - kp; if (dq > 128 || dq < -128) v = -1e30f; }
        sc[qi][kt][r] = v; mx = fmaxf(mx, v); }
    mx = max_x16_x32(mx);
    const float mnew = fmaxf(mrun[qi], mx);
    const float alpha = __builtin_amdgcn_exp2f(mrun[qi] - mnew);
    mrun[qi] = mnew;
    float ps = 0.f;
#pragma unroll
    for (int kt = 0; kt < 4; ++kt)
#pragma unroll
      for (int r = 0; r < 4; ++r) { float pvv = __builtin_amdgcn_exp2f(sc[qi][kt][r] - mnew); ps += pvv; sc[qi][kt][r] = pvv; }
    pf[qi][0] = pack8(sc[qi][0][0], sc[qi][0][1], sc[qi][0][2], sc[qi][0][3], sc[qi][1][0], sc[qi][1][1], sc[qi][1][2], sc[qi][1][3]);
    pf[qi][1] = pack8(sc[qi][2][0], sc[qi][2][1], sc[qi][2][2], sc[qi][2][3], sc[qi][3][0], sc[qi][3][1], sc[qi][3][2], sc[qi][3][3]);
    lrun[qi] = lrun[qi] * alpha + ps;
#pragma unroll
    for (int dt = 0; dt < 4; ++dt) O[qi][dt] *= alpha;
  }
#pragma unroll
  for (int dt = 0; dt < 4; ++dt)
#pragma unroll
    for (int sub = 0; sub < 2; ++sub) {
      const unsigned char* vp = Vl + ((dt * 16 + fr) * VP + sub * 32 + fq * 4) * 2;
      u32x2 v0 = *reinterpret_cast<const u32x2*>(vp), v1 = *reinterpret_cast<const u32x2*>(vp + 32);
      u32x4 vv = {v0[0], v0[1], v1[0], v1[1]};
      bf16x8 vf = *reinterpret_cast<bf16x8*>(&vv);
      O[0][dt] = mfma16(vf, pf[0][sub], O[0][dt]); O[1][dt] = mfma16(vf, pf[1][sub], O[1][dt]);
    }
}

template <int KS>
DEV void attn_block(const bf16* Q, int ldq, const bf16* Kb, const bf16* Vt, int a_lo, int a_hi, int b_lo, int b_hi, bool maskA, int qpos_blk,
                    float scale, bool has_sink, float sink, bf16* out, int ldo) {
  extern __shared__ __attribute__((aligned(16))) unsigned char smem[];
  const int tidx_ = opaque_tid();
  constexpr int DK = KS * 32, KP = DK + 8, VP = 72, KV8 = DK / 8;
  constexpr int KBYTES = 64 * KP * 2, VBYTES = 64 * VP * 2;
  const int lane = tidx_ & 63, wv = __builtin_amdgcn_readfirstlane(tidx_ >> 6), fr = lane & 15, fq = lane >> 4;
  const float L2E = 1.4426950408889634f;
  const bf16* Qw = Q + (size_t)(wv * 32) * ldq;
  bf16x8 qf[2][KS];
#pragma unroll
  for (int qi = 0; qi < 2; ++qi)
#pragma unroll
    for (int kk = 0; kk < KS; ++kk) qf[qi][kk] = ldg8(Qw + (size_t)(qi * 16 + fr) * ldq + kk * 32 + fq * 8);
  f32x4 O[2][4];
  float mrun[2], lrun[2];
  const float sl2 = scale * L2E;
#pragma unroll
  for (int qi = 0; qi < 2; ++qi) { mrun[qi] = has_sink ? sink * L2E : -1e30f; lrun[qi] = (has_sink && fq == 0) ? 1.f : 0.f;
#pragma unroll
    for (int dt = 0; dt < 4; ++dt) O[qi][dt] = (f32x4){0.f, 0.f, 0.f, 0.f}; }
  const int nA = a_hi - a_lo, nB = b_hi - b_lo, n = nA + nB;
  const int qw0 = qpos_blk + wv * 32;
  const int kv0 = tidx_, kv1 = tidx_ + 512;
  const int kr0 = kv0 / KV8, kc0 = kv0 % KV8, kr1 = kv1 / KV8, kc1 = kv1 % KV8;
  const bool has1 = kv1 < 64 * KV8;
  const int vd = tidx_ >> 3, vpart = tidx_ & 7;
  const int koff0 = (kr0 * KP + kc0 * 8) * 2, koff1 = (kr1 * KP + kc1 * 8) * 2, voff = 2 * KBYTES + (vd * VP + vpart * 8) * 2;
  bf16x8 a0, a1, av, b0, b1, bv;
  a1 = (bf16x8){0, 0, 0, 0, 0, 0, 0, 0}; b0 = a1; b1 = a1; bv = a1;
#define CH_OF(i_) ((i_) < nA ? a_lo + (i_) : b_lo + ((i_) - nA))
#define LOADSET(r0_, r1_, rv_, i_) do { const int kn_ = CH_OF(i_) * 64; \
    r0_ = ldg8(Kb + (size_t)(kn_ + kr0) * DK + kc0 * 8); if (has1) r1_ = ldg8(Kb + (size_t)(kn_ + kr1) * DK + kc1 * 8); \
    rv_ = ldg8(Vt + (size_t)vd * NKEY + kn_ + vpart * 8); } while (0)
#define STORESET(r0_, r1_, rv_, i_) do { unsigned char* kb_ = smem + ((i_) & 1) * KBYTES; \
    *reinterpret_cast<bf16x8*>(kb_ + koff0) = r0_; if (has1) *reinterpret_cast<bf16x8*>(kb_ + koff1) = r1_; \
    *reinterpret_cast<bf16x8*>(smem + voff + ((i_) & 1) * VBYTES) = rv_; } while (0)
#define BODY(it_, L0, L1, LV, S0, S1, SV) do { \
    if ((it_) + 2 < n) LOADSET(L0, L1, LV, (it_) + 2); \
    { const int c_ = CH_OF(it_); const bool masked_ = maskA && ((it_) < nA); const int key0_ = c_ * 64; \
      const bool active_ = !masked_ || !(key0_ + 63 < qw0 - 128 || key0_ > qw0 + 159); \
      if (active_) attn_chunk<KS>(smem + ((it_) & 1) * KBYTES, smem + 2 * KBYTES + ((it_) & 1) * VBYTES, qf, O, mrun, lrun, masked_, key0_, qw0, sl2, lane, fr, fq); } \
    if ((it_) + 1 < n) STORESET(S0, S1, SV, (it_) + 1); \
    asm volatile("s_waitcnt lgkmcnt(0)" ::: "memory"); __builtin_amdgcn_s_barrier(); asm volatile("" ::: "memory"); } while (0)
  LOADSET(a0, a1, av, 0);
  STORESET(a0, a1, av, 0);
  if (n > 1) LOADSET(b0, b1, bv, 1);
  __syncthreads();
#pragma unroll 1
  for (int it = 0; it < n; it += 2) {
    BODY(it, a0, a1, av, b0, b1, bv);
    if (it + 1 < n) BODY(it + 1, b0, b1, bv, a0, a1, av);
  }
#undef BODY
#undef LOADSET
#undef STORESET
#undef CH_OF
  bf16* outw = out + (size_t)(wv * 32) * ldo;
#pragma unroll
  for (int qi = 0; qi < 2; ++qi) {
    const float l = sum_x16_x32(lrun[qi]);
    const float inv = 1.f / l;
#pragma unroll
    for (int dt = 0; dt < 4; ++dt)
      stg4(outw + (size_t)(qi * 16 + fr) * ldo + dt * 16 + fq * 4, pack4(O[qi][dt][0] * inv, O[qi][dt][1] * inv, O[qi][dt][2] * inv, O[qi][dt][3] * inv));
  }
}

DEV void mla_item(const Params& p, int i) {
  const bf16* KMLA = reinterpret_cast<const bf16*>(p.ws + O_KMLA); const bf16* VTMLA = reinterpret_cast<const bf16*>(p.ws + O_VTMLA);
  const bf16* QMLA = reinterpret_cast<const bf16*>(p.ws + O_QMLA); bf16* YBR = reinterpret_cast<bf16*>(p.ws + O_H);
  int b, h, t, lo, hi;
  if (i < 256) { b = i >> 5; h = (i >> 3) & 3; t = b * 2048 + (i & 7) * 256; lo = 0; hi = 36; }
  else { int j = i - 256; b = j >> 2; h = j & 3; t = TL + b * 256; lo = 32; hi = 36; }
  attn_block<3>(QMLA + (size_t)t * 384 + h * 96, 384, KMLA + (size_t)(b * 4 + h) * NKEY * 96, VTMLA + (size_t)(b * 4 + h) * 64 * NKEY,
                lo, hi, 0, 0, false, 0, 0.10206207261596577f, false, 0.f, YBR + (size_t)t * 256 + h * 64, 256);
}
DEV void gqa_item(const Params& p, int l, int i) {
  const bf16* GQ = reinterpret_cast<const bf16*>(p.ws + O_GQ); const bf16* GK = reinterpret_cast<const bf16*>(p.ws + O_GK);
  const bf16* GVT = reinterpret_cast<const bf16*>(p.ws + O_GVT); bf16* YBR1 = reinterpret_cast<bf16*>(p.ws + O_H) + (size_t)T * 256;
  int b, hq, t, alo = 0, ahi = 0, qp = 0;
  if (i < 256) { b = i >> 5; hq = (i >> 3) & 3; qp = (i & 7) * 256; t = b * 2048 + qp;
    alo = max(0, qp - 128) >> 6; ahi = (min(2047, qp + 383) >> 6) + 1; }
  else { int j = i - 256; b = j >> 2; hq = j & 3; t = TL + b * 256; }
  const int kvh = hq >> 1;
  const float sink = p.in[15][l * 4 + hq];
  attn_block<2>(GQ + (size_t)t * 256 + hq * 64, 256, GK + (size_t)(b * 2 + kvh) * NKEY * 64, GVT + (size_t)(b * 2 + kvh) * 64 * NKEY,
                alo, ahi, 32, 36, true, qp, 0.125f, true, sink, YBR1 + (size_t)t * 256 + hq * 64, 256);
}

DEV int s5_token(int b, int dir, int s) {
  if (s < 256) { int pos = dir ? 255 - s : s; return TL + b * 256 + pos; }
  int q = s - 256; int pos = dir ? 2047 - q : q; return b * 2048 + pos;
}
DEV void s5_disc(const Params& p, int gi, int pp, float& a_re, float& a_im, float& cre, float& cim) {
  float lre = fminf(p.in[16][gi * 64 + pp], -1e-4f), lim = p.in[17][gi * 64 + pp];
  const float dt = expf(p.in[18][gi]);
  const float mag = expf(lre * dt);
  float sn, cs; sincos_acc(lim * dt, sn, cs);
  a_re = mag * cs; a_im = mag * sn;
  const float nr = a_re - 1.f, ni = a_im, den = lre * lre + lim * lim;
  cre = (nr * lre + ni * lim) / den; cim = (ni * lre - nr * lim) / den;
}
DEV void s5_item(const Params& p, int l, int item) {
  extern __shared__ __attribute__((aligned(16))) unsigned char smem[];
  const int tidx_ = opaque_tid();
  const int b = item >> 5, g = (item >> 1) & 15, dir = item & 1;
  const int lane = tidx_ & 63, wv = __builtin_amdgcn_readfirstlane(tidx_ >> 6), fr = lane & 15, fq = lane >> 4;
  constexpr int WB = 12800, BUP = 132;
  float* Bu = reinterpret_cast<float*>(smem + wv * WB);
  unsigned short* Sst = reinterpret_cast<unsigned short*>(smem + wv * WB + 8448);
  float* Ex = reinterpret_cast<float*>(smem + 8 * WB);
  const bf16* PROJ = reinterpret_cast<const bf16*>(p.ws + O_PROJ);
  float* S5Y = reinterpret_cast<float*>(p.ws + O_Y) + (size_t)dir * T * 256;
  const int gi = (l * 2 + dir) * 16 + g;
  float a_re, a_im, cre_, cim_;
  s5_disc(p, gi, lane, a_re, a_im, cre_, cim_);
  bf16x8 bbf[8];
#pragma unroll
  for (int tl = 0; tl < 4; ++tl) {
    const int pp = tl * 16 + fr;
    float ar2, ai2, cr2, ci2; s5_disc(p, gi, pp, ar2, ai2, cr2, ci2);
    float vr[8], vi[8];
    const float* br = p.in[19] + ((size_t)gi * 64 + pp) * 16 + (fq & 1) * 8; const float* bi = p.in[20] + ((size_t)gi * 64 + pp) * 16 + (fq & 1) * 8;
#pragma unroll
    for (int e = 0; e < 8; ++e) { const float r0 = br[e], i0 = bi[e]; vr[e] = (fq < 2) ? (cr2 * r0 - ci2 * i0) : 0.f; vi[e] = (fq < 2) ? (cr2 * i0 + ci2 * r0) : 0.f; }
    bbf[tl] = pack8(vr[0], vr[1], vr[2], vr[3], vr[4], vr[5], vr[6], vr[7]);
    bbf[4 + tl] = pack8(vi[0], vi[1], vi[2], vi[3], vi[4], vi[5], vi[6], vi[7]);
  }
  bf16x8 cf[4];
#pragma unroll
  for (int kk = 0; kk < 4; ++kk) {
    const float* src = (kk < 2 ? p.in[21] : p.in[22]) + ((size_t)gi * 16 + fr) * 64 + (kk & 1) * 32 + fq * 8;
    const float sg = kk < 2 ? 1.f : -1.f;
    cf[kk] = pack8(sg * src[0], sg * src[1], sg * src[2], sg * src[3], sg * src[4], sg * src[5], sg * src[6], sg * src[7]);
  }
  const int sbase = wv * 288;
  float sre = 0.f, sim = 0.f;
#pragma unroll 1
  for (int pass = 0; pass < 2; ++pass) {
    bf16x8 uf = (bf16x8){0, 0, 0, 0, 0, 0, 0, 0};
    if (fq < 2) uf = ldg8(PROJ + (size_t)s5_token(b, dir, sbase + fr) * INP + C_U + g * 16 + fq * 8);
#pragma unroll 1
    for (int sc = 0; sc < 18; ++sc) {
      const int s0 = sbase + sc * 16;
#pragma unroll
      for (int tl = 0; tl < 8; ++tl) {
        f32x4 d = mfma16(uf, bbf[tl], (f32x4){0.f, 0.f, 0.f, 0.f});
#pragma unroll
        for (int r = 0; r < 4; ++r) Bu[(fq * 4 + r) * BUP + tl * 16 + fr] = d[r];
      }
      if (sc + 1 < 18) { if (fq < 2) uf = ldg8(PROJ + (size_t)s5_token(b, dir, s0 + 16 + fr) * INP + C_U + g * 16 + fq * 8); }
      float bur[16], bui[16];
#pragma unroll
      for (int tt = 0; tt < 16; ++tt) { bur[tt] = Bu[tt * BUP + lane]; bui[tt] = Bu[tt * BUP + 64 + lane]; }
      if (pass == 0) {
#pragma unroll
        for (int tt = 0; tt < 16; ++tt) {
          const float nre = a_re * sre - a_im * sim + bur[tt], nim = a_re * sim + a_im * sre + bui[tt];
          sre = nre; sim = nim;
        }
      } else {
#pragma unroll
        for (int tt = 0; tt < 16; ++tt) {
          const float nre = a_re * sre - a_im * sim + bur[tt], nim = a_re * sim + a_im * sre + bui[tt];
          sre = nre; sim = nim;
          const unsigned pk = pk2(sre, sim); Sst[tt * 136 + lane] = (unsigned short)(pk & 0xffffu); Sst[tt * 136 + 64 + lane] = (unsigned short)(pk >> 16);
        }
      }
      if (pass == 1) {
        f32x4 acc = {0.f, 0.f, 0.f, 0.f};
#pragma unroll
        for (int kk = 0; kk < 4; ++kk) { bf16x8 sf = *reinterpret_cast<const bf16x8*>(Sst + fr * 136 + kk * 32 + fq * 8); acc = mfma16(cf[kk], sf, acc); }
        const int tok = s5_token(b, dir, s0 + fr);
        *reinterpret_cast<f32x4*>(S5Y + (size_t)tok * 256 + g * 16 + fq * 4) = acc;
      }
    }
    if (pass == 0) {
      Ex[wv * 128 + lane] = sre; Ex[wv * 128 + 64 + lane] = sim;
      __syncthreads();
      float pr = 1.f, pi = 0.f;
#pragma unroll 1
      for (int i = 0; i < 288; ++i) { float t1 = pr * a_re - pi * a_im, t2 = pr * a_im + pi * a_re; pr = t1; pi = t2; }
      float cr = 0.f, ci = 0.f;
      for (int w2 = 0; w2 < wv; ++w2) { float er = Ex[w2 * 128 + lane], ei = Ex[w2 * 128 + 64 + lane];
        float t1 = pr * cr - pi * ci + er, t2 = pr * ci + pi * cr + ei; cr = t1; ci = t2; }
      sre = cr; sim = ci;
    }
  }
}

DEV void gmlp_item(const Params& p, int l, int item) {
  const int tidx_ = opaque_tid();
  extern __shared__ __attribute__((aligned(16))) unsigned char smem[];
  unsigned short* vT = reinterpret_cast<unsigned short*>(smem);
  const bf16* PROJ = reinterpret_cast<const bf16*>(p.ws + O_PROJ);
  const bf16* WS = reinterpret_cast<const bf16*>(p.ws + (size_t)(l & 1) * WSZ + O_WSP);
  bf16* YBR3 = reinterpret_cast<bf16*>(p.ws + O_H) + (size_t)3 * T * 256;
  const float* gn = p.in[26] + l * 256; const float* bs = p.in[28] + l * 512;
  const int lane = tidx_ & 63, wv = __builtin_amdgcn_readfirstlane(tidx_ >> 6), fr = lane & 15, fq = lane >> 4;
  const int t0 = item * 128;
  f32x4 g4 = *reinterpret_cast<const f32x4*>(gn + lane * 4);
  us4 raws[16];
#pragma unroll
  for (int i = 0; i < 16; ++i) raws[i] = ldg4(PROJ + (size_t)(t0 + wv * 16 + i) * INP + C_Z + 256 + lane * 4);
#pragma unroll
  for (int i = 0; i < 16; ++i) {
    const int tk = wv * 16 + i;
    const us4 raw = raws[i];
    float v[4]; float s = 0.f;
#pragma unroll
    for (int e = 0; e < 4; ++e) { v[e] = geluf_(bf2f(raw[e])); s += v[e]; }
    const float mean = wave_sum(s, lane) * (1.f / 256.f);
    float q = 0.f;
#pragma unroll
    for (int e = 0; e < 4; ++e) { v[e] -= mean; q += v[e] * v[e]; }
    const float rstd = rsqrtf(wave_sum(q, lane) * (1.f / 256.f) + 1e-5f);
#pragma unroll
    for (int e = 0; e < 4; ++e) vT[(lane * 4 + e) * 136 + tk] = f2bf(v[e] * rstd * g4[e]);
  }
  __syncthreads();
  const int i0 = wv * 16; const int tok = t0 + i0 + fr;
#pragma unroll 1
  for (int g = 0; g < 4; ++g) {
  bf16x8 wf[4]; us4 urs[4];
#pragma unroll
  for (int kk = 0; kk < 4; ++kk) wf[kk] = ldg8(WS + (size_t)(g * 128 + i0 + fr) * 128 + kk * 32 + fq * 8);
#pragma unroll
  for (int c4 = 0; c4 < 4; ++c4) urs[c4] = ldg4(PROJ + (size_t)tok * INP + C_Z + (g * 4 + c4) * 16 + fq * 4);
  const float bias = bs[g * 128 + i0 + fr];
#pragma unroll
  for (int c4 = 0; c4 < 4; ++c4) {
    const int ct = g * 4 + c4;
    f32x4 acc = {0.f, 0.f, 0.f, 0.f};
#pragma unroll
    for (int kk = 0; kk < 4; ++kk) {
      bf16x8 af = *reinterpret_cast<const bf16x8*>(vT + (ct * 16 + fr) * 136 + kk * 32 + fq * 8);
      acc = mfma16(af, wf[kk], acc);
    }
    const us4 ur = urs[c4];
    stg4(YBR3 + (size_t)tok * 256 + ct * 16 + fq * 4,
         pack4(geluf_(bf2f(ur[0])) * (acc[0] + bias), geluf_(bf2f(ur[1])) * (acc[1] + bias), geluf_(bf2f(ur[2])) * (acc[2] + bias), geluf_(bf2f(ur[3])) * (acc[3] + bias)));
  }
  }
}

DEV void flag_arrive(unsigned* flag);
DEV void flag_wait(unsigned* flag, unsigned need);
DEV void m3_item(const Params& p, int l, int item) {
  extern __shared__ __attribute__((aligned(16))) unsigned char smem[];
  const int tidx_ = opaque_tid();
  const bf16* PROJ = reinterpret_cast<const bf16*>(p.ws + O_PROJ);
  const float* Y0 = reinterpret_cast<const float*>(p.ws + O_Y); const float* Y1 = Y0 + (size_t)T * 256;
  const bf16* WGLU = reinterpret_cast<const bf16*>(p.ws + (size_t)(l & 1) * WSZ + O_WGLU);
  bf16* YBR2 = reinterpret_cast<bf16*>(p.ws + O_H) + (size_t)2 * T * 256;
  const float* dsk = p.in[23] + l * 256; const float* bg = p.in[25] + l * 512;
  const int lane = tidx_ & 63, wv = __builtin_amdgcn_readfirstlane(tidx_ >> 6), fr = lane & 15, fq = lane >> 4;
  constexpr int AP = 264;
  unsigned short* As = reinterpret_cast<unsigned short*>(smem);
  {
    const int t0 = item * 64;
    {
      const int tk = tidx_ >> 3, c0 = (tidx_ & 7) * 32; const int tok = t0 + tk;
#pragma unroll
      for (int q = 0; q < 4; ++q) {
        const int ch0 = c0 + q * 8;
        bf16x8 ur = ldg8(PROJ + (size_t)tok * INP + C_U + ch0);
        float gv[8];
#pragma unroll
        for (int hh = 0; hh < 2; ++hh) {
          f32x4 y0 = *reinterpret_cast<const f32x4*>(Y0 + (size_t)tok * 256 + ch0 + hh * 4);
          f32x4 y1 = *reinterpret_cast<const f32x4*>(Y1 + (size_t)tok * 256 + ch0 + hh * 4);
          f32x4 d4 = *reinterpret_cast<const f32x4*>(dsk + ch0 + hh * 4);
#pragma unroll
          for (int e = 0; e < 4; ++e) gv[hh * 4 + e] = geluf_(y0[e] + y1[e] + d4[e] * bfs2f(ur[hh * 4 + e]));
        }
        *reinterpret_cast<bf16x8*>(As + tk * AP + ch0) = pack8(gv[0], gv[1], gv[2], gv[3], gv[4], gv[5], gv[6], gv[7]);
      }
    }
    __syncthreads();
    f32x4 aa[4][2], ag[4][2];
#pragma unroll
    for (int m = 0; m < 4; ++m)
#pragma unroll
      for (int n = 0; n < 2; ++n) { aa[m][n] = (f32x4){0.f, 0.f, 0.f, 0.f}; ag[m][n] = (f32x4){0.f, 0.f, 0.f, 0.f}; }
#pragma unroll 2
    for (int kk = 0; kk < 8; ++kk) {
      bf16x8 wa[2], wg[2], af[4];
#pragma unroll
      for (int n = 0; n < 2; ++n) { const int nt = wv + n * 8;
        wa[n] = ldg8(WGLU + (size_t)(nt * 16 + fr) * 256 + kk * 32 + fq * 8);
        wg[n] = ldg8(WGLU + (size_t)(256 + nt * 16 + fr) * 256 + kk * 32 + fq * 8); }
#pragma unroll
      for (int m = 0; m < 4; ++m) af[m] = *reinterpret_cast<const bf16x8*>(As + (m * 16 + fr) * AP + kk * 32 + fq * 8);
#pragma unroll
      for (int m = 0; m < 4; ++m)
#pragma unroll
        for (int n = 0; n < 2; ++n) { aa[m][n] = mfma16(wa[n], af[m], aa[m][n]); ag[m][n] = mfma16(wg[n], af[m], ag[m][n]); }
    }
#pragma unroll
    for (int n = 0; n < 2; ++n) {
      const int ncol = (wv + n * 8) * 16 + fq * 4;
      f32x4 ba = *reinterpret_cast<const f32x4*>(bg + ncol), bgg = *reinterpret_cast<const f32x4*>(bg + 256 + ncol);
#pragma unroll
      for (int m = 0; m < 4; ++m) {
        const int tok = t0 + m * 16 + fr;
        float o[4];
#pragma unroll
        for (int r = 0; r < 4; ++r) o[r] = (aa[m][n][r] + ba[r]) * sigmoidf_(ag[m][n][r] + bgg[r]);
        stg4(YBR2 + (size_t)tok * 256 + ncol, pack4(o[0], o[1], o[2], o[3]));
      }
    }
    __syncthreads();
  }
}

DEV void m2_phase(const Params& p, int l) {
  extern __shared__ __attribute__((aligned(16))) unsigned char smem[];
  const bool last = (l == 3);
  volatile unsigned* nxt = reinterpret_cast<volatile unsigned*>(smem + 131072 + 32);
  unsigned* counter = reinterpret_cast<unsigned*>(p.ws + O_BAR) + 3712 + l;
  const int total = last ? (256 + 256 + 128) : (256 + 256 + 144 + 32 + 32);
  unsigned* s5flag = reinterpret_cast<unsigned*>(p.ws + O_BAR) + 3720 + l * 8;
  unsigned* m1flag = reinterpret_cast<unsigned*>(p.ws + O_BAR) + 3752 + l * 8;
  for (int item = blockIdx.x; item < T / 64; item += gridDim.x) { m1_item(p, l, item); flag_arrive(m1flag + (item < 256 ? (item >> 5) : ((item - 256) >> 2))); __syncthreads(); }
  for (int item = blockIdx.x; item < 256; item += gridDim.x) { s5_item(p, l, item); flag_arrive(s5flag + (item >> 5)); __syncthreads(); }
  unsigned seen = 0u;
#define NEED_M1(b_) do { const int bb_ = (b_); if (!((seen >> bb_) & 1u)) { flag_wait(m1flag + bb_, 36u); seen |= 1u << bb_; } } while (0)
  const int n3 = last ? 256 : 288;
  const int ng = last ? 128 : 144;
  for (;;) {
    if (threadIdx.x == 0) *nxt = __hip_atomic_fetch_add(counter, 1u, __ATOMIC_RELAXED, __HIP_MEMORY_SCOPE_AGENT);
    __syncthreads();
    const int q = (int)*nxt;
    __syncthreads();
    if (q >= total + n3) break;
    if (q >= total) {
      const int i3 = q - total; const int b3 = i3 < 256 ? (i3 >> 5) : ((i3 - 256) >> 2);
      flag_wait(s5flag + b3, 32u);
      m3_item(p, l, i3);
    }
    else if (q < 256) { NEED_M1(q >> 5); mla_item(p, q); }
    else if (q < 256 + ng) gmlp_item(p, l, q - 256);
    else if (q < 512 + ng) { NEED_M1((q - 256 - ng) >> 5); gqa_item(p, l, q - 256 - ng); }
    else if (q < 688) { NEED_M1((q - 656) >> 2); mla_item(p, 256 + (q - 656)); }
    else { NEED_M1((q - 688) >> 2); gqa_item(p, l, 256 + (q - 688)); }
    __syncthreads();
  }
#undef NEED_M1
}

#define XB_TMO      128
#define XB_XCNT(j)  (256  + 64 * (j))
#define XB_XSUB(j)  (1280 + 64 * (j))
#define XB_XGEN(j)  (2304 + 64 * (j))
#define XB_TOP      3328
#define XB_TOPGEN   3392
#define XCD_BAR_WORDS 3456
#define XB_SPIN_CAP (1u << 22)
#define LAS __attribute__((address_space(3)))
DEV unsigned xb_ld(unsigned* p) { return __hip_atomic_load(p, __ATOMIC_RELAXED, __HIP_MEMORY_SCOPE_AGENT); }
DEV unsigned xb_add(unsigned* p, unsigned v) { return __hip_atomic_fetch_add(p, v, __ATOMIC_RELAXED, __HIP_MEMORY_SCOPE_AGENT); }
DEV unsigned xb_xcc_id() { return (unsigned)__builtin_amdgcn_s_getreg((3 << 11) | 20) & 0xFu; }
#define XB_SPIN(cond, bar) do { unsigned _sp = 0; while (cond) { __builtin_amdgcn_s_sleep(1); \
    if ((++_sp & 255u) == 0u) { if (xb_ld(&(bar)[XB_TMO])) break; if (_sp > XB_SPIN_CAP) { atomicAdd(&(bar)[XB_TMO], 1u); break; } } } } while (0)
struct XcdBarrier { unsigned* bar; unsigned x; volatile LAS unsigned* st; };
DEV XcdBarrier xcd_barrier_post(unsigned* bar, volatile LAS unsigned* st) {
  XcdBarrier b; b.bar = bar; b.x = xb_xcc_id(); b.st = st;
  if (threadIdx.x == 0) (void)xb_add(&bar[XB_XCNT(b.x)], 1u);
  return b;
}
DEV void xcd_barrier_complete(unsigned* bar, unsigned x, unsigned& nloc, unsigned& nx) {
  const unsigned G = gridDim.x * gridDim.y * gridDim.z;
  unsigned sum, cnt, mine, sp = 0u;
  for (;;) {
    sum = 0u; cnt = 0u; mine = 0u;
#pragma unroll
    for (unsigned j = 0; j < 16; ++j) { const unsigned c = xb_ld(&bar[XB_XCNT(j)]); sum += c; cnt += (c > 0u) ? 1u : 0u; mine = (j == x) ? c : mine; }
    if (sum == G) break;
    __builtin_amdgcn_s_sleep(1);
    if ((++sp & 255u) == 0u) { if (xb_ld(&bar[XB_TMO])) break; if (sp > XB_SPIN_CAP) { atomicAdd(&bar[XB_TMO], 1u); break; } }
  }
  nloc = mine > 0u ? mine : 1u; nx = cnt > 0u ? cnt : 1u;
}
DEV void xcd_barrier(const XcdBarrier& b) {
  asm volatile("s_waitcnt vmcnt(0)" ::: "memory");
  __syncthreads();
  if (threadIdx.x == 0) {
    unsigned* bar = b.bar;
    __builtin_amdgcn_s_waitcnt(0);
    unsigned nloc = b.st[0], nx = b.st[1];
    if (nloc == 0u) { xcd_barrier_complete(bar, b.x, nloc, nx); b.st[0] = nloc; b.st[1] = nx; }
    const unsigned old = xb_add(&bar[XB_XSUB(b.x)], 1u);
    const unsigned gen = old / nloc;
    if (old + 1u == (gen + 1u) * nloc) {
      __builtin_amdgcn_fence(__ATOMIC_RELEASE, "agent");
      asm volatile("s_waitcnt vmcnt(0)" ::: "memory");
      const unsigned og = xb_add(&bar[XB_TOP], 1u);
      const unsigned tg = og / nx;
      if (og + 1u == (tg + 1u) * nx) xb_add(&bar[XB_TOPGEN], 1u);
      else XB_SPIN(xb_ld(&bar[XB_TOPGEN]) == tg, bar);
      __builtin_amdgcn_fence(__ATOMIC_ACQUIRE, "agent");
      xb_add(&bar[XB_XGEN(b.x)], 1u);
      asm volatile("s_waitcnt vmcnt(0)" ::: "memory");
    } else {
      XB_SPIN(xb_ld(&bar[XB_XGEN(b.x)]) == gen, bar);
      __builtin_amdgcn_fence(__ATOMIC_ACQUIRE, "agent");
      asm volatile("s_waitcnt vmcnt(0)" ::: "memory");
    }
  }
  __syncthreads();
}

DEV void signal_wait(unsigned* flag, unsigned need) {
  asm volatile("s_waitcnt vmcnt(0)" ::: "memory");
  __syncthreads();
  if (threadIdx.x == 0) {
    __builtin_amdgcn_fence(__ATOMIC_RELEASE, "agent");
    asm volatile("s_waitcnt vmcnt(0)" ::: "memory");
    xb_add(flag, 1u);
    unsigned sp = 0;
    while (xb_ld(flag) < need) { __builtin_amdgcn_s_sleep(2); if (++sp > (1u << 24)) break; }
    __builtin_amdgcn_fence(__ATOMIC_ACQUIRE, "agent");
    asm volatile("s_waitcnt vmcnt(0)" ::: "memory");
  }
  __syncthreads();
}

DEV void flag_arrive(unsigned* flag) {
  asm volatile("s_waitcnt vmcnt(0)" ::: "memory");
  __syncthreads();
  if (threadIdx.x == 0) {
    __builtin_amdgcn_fence(__ATOMIC_RELEASE, "agent");
    asm volatile("s_waitcnt vmcnt(0)" ::: "memory");
    xb_add(flag, 1u);
  }
}
DEV void flag_wait(unsigned* flag, unsigned need) {
  if (threadIdx.x == 0) {
    unsigned sp = 0;
    while (xb_ld(flag) < need) { __builtin_amdgcn_s_sleep(2); if (++sp > (1u << 24)) break; }
    __builtin_amdgcn_fence(__ATOMIC_ACQUIRE, "agent");
    asm volatile("s_waitcnt vmcnt(0)" ::: "memory");
  }
  __syncthreads();
}

constexpr int NPHASE = 2 + 13 * 4;

DEV void run_phase(const Params& p, int ph) {
  unsigned char* ws = p.ws;
  bf16* H = reinterpret_cast<bf16*>(ws + O_H);
  bf16* PROJ = reinterpret_cast<bf16*>(ws + O_PROJ);
  float* Y = reinterpret_cast<float*>(ws + O_Y);
  bf16* MRG = reinterpret_cast<bf16*>(ws + O_MRG);
  const int G = gridDim.x;
  const int wv_ = __builtin_amdgcn_readfirstlane(opaque_tid() >> 6);
  if (ph == 0) { if (EMASK & 0x2000) { mod_phase(p); __syncthreads(); conv_phase(p, 0, blockIdx.x, G, 0); } return; }
  if (ph == 1) { if (EMASK & 0x4000) e_phase(p, 0, 0, 0, T, blockIdx.x * 8 + wv_, G * 8, false); return; }
  const int l = (ph - 2) / 13, k = (ph - 2) % 13;
  const bool last = (l == 3);
  unsigned char* wsl = ws + (size_t)(l & 1) * WSZ;
  const bf16* WFI = reinterpret_cast<const bf16*>(wsl + O_WFI);
  const bf16* WFO = reinterpret_cast<const bf16*>(wsl + O_WFO);
  const bf16* WBR = reinterpret_cast<const bf16*>(wsl + O_WBR);
  const bf16* WOUT = reinterpret_cast<const bf16*>(wsl + O_WOUT);
  unsigned* flags = reinterpret_cast<unsigned*>(ws + O_BAR) + 3584 + l * 32;
  if (!((EMASK >> k) & 1)) return;
  switch (k) {
    case 0: case 10: {
      const int j = (k == 0) ? 0 : 1;
      const int M = (last && j == 1) ? TL : T;
      gemm_phase(j == 0 ? H : reinterpret_cast<const bf16*>(ws + O_H2), 1024, WFI + (size_t)j * 5632 * 1024, 1024, M, 5632, 1024, EpiSwiglu{PROJ});
      if (!last) {
        const int ntile = (M / 256) * 22, rem = ntile % G;
        if (rem != 0 && vblock() >= rem) { __syncthreads(); conv_phase(p, l + 1, vblock() - rem, G - rem, j == 0 ? 1 : 2); }
      }
    } break;
    case 1: case 11: {
      const int j = (k == 1) ? 0 : 1;
      gemm_phase(PROJ, 2816, WFO + (size_t)j * 1024 * 2816, 2816, TL, 1024, 2816, EpiF32{reinterpret_cast<bf16*>(Y)});
    } break;
    case 3: {
      const bf16* WIN = reinterpret_cast<const bf16*>(wsl + O_WIN);
      if (!last) gemm_phase(H, 1024, WIN, 1024, T, INP, 1024, EpiBf16{PROJ});
      else {
        EpiBf16 e{PROJ};
        for (int t = vblock(); t < 64 * 23 + 8 * 3; t += G) {
          int pm, pn;
          if (t < 64 * 23) tile_of(t, 64, 23, pm, pn); else { pm = 64 + (t - 64 * 23) / 3; pn = (t - 64 * 23) % 3; }
          gemm_tile(H, 1024, WIN, 1024, 1024, pm * 256, pn * 256, e);
        }
      }
    } break;
    case 4: break;
    case 5: m2_phase(p, l); break;
    case 6: break;
    case 7: {
      const int nM = TL / 256, nN = 4, ntile = nM * nN;
      for (int t = vblock(); t < ntile; t += G) {
        int pm, pn; tile_of(t, nM, nN, pm, pn);
        EpiBranch e{PROJ, MRG};
        gemm_tile_nb<EpiBranch, 4>(H, 256, (long)T * 256, WBR, 256, (long)1024 * 256, 256, pm * 256, pn * 256, e);
      }
    } break;
    case 8: gemm_phase(MRG, 1024, WOUT, 1024, TL, 1024, 1024, EpiF32{reinterpret_cast<bf16*>(Y)}); break;
    case 2: case 9: case 12: {
      const int mode = (k == 2) ? 1 : (k == 9) ? 2 : 3;
      const bool ctxwork = !(last && mode >= 2);
      if (ctxwork && blockIdx.x < 64) {
        const int c = blockIdx.x, pmc = 64 + (c >> 3), nt = (c >> 1) & 3, kh = c & 1;
        unsigned* fl = flags + (mode - 1) * 8 + (pmc - 64);
        float* Yc = reinterpret_cast<float*>(ws + O_Y + 37748736) + (size_t)kh * 2048 * 1024;
        EpiF32c ec{Yc};
        if (mode == 2) {
          unsigned* fla = flags + 24 + (pmc - 64);
          if (kh == 0) {
            EpiBranch e{PROJ, MRG};
            gemm_tile_nb<EpiBranch, 4>(H, 256, (long)T * 256, WBR, 256, (long)1024 * 256, 256, pmc * 256, nt * 256, e);
            flag_arrive(fla);
          }
          flag_wait(fla, 4u);
          gemm_tile(MRG + kh * 512, 1024, WOUT + kh * 512, 1024, 512, pmc * 256, nt * 256, ec);
        } else {
          const int j2 = (mode == 1) ? 0 : 1;
          gemm_tile(PROJ + kh * 1408, 2816, WFO + (size_t)j2 * 1024 * 2816 + kh * 1408, 2816, 1408, pmc * 256, nt * 256, ec);
        }
        flag_arrive(fl);
        flag_wait(fl, 8u);
        const int r0 = pmc * 256 + (c & 7) * 32;
        e_phase(p, l, mode, r0, r0 + 32, wv_, 8, true);
      } else if (ctxwork) {
        e_phase(p, l, mode, 0, TL, (blockIdx.x - 64) * 8 + wv_, (G - 64) * 8, false);
      } else {
        e_phase(p, l, mode, 0, TL, blockIdx.x * 8 + wv_, G * 8, false);
      }

    } break;
  }
}

__global__ void __launch_bounds__(512, 2) fwd_kernel(Params p) {
  extern __shared__ __attribute__((aligned(16))) unsigned char smem[];
  volatile LAS unsigned* stw = (volatile LAS unsigned*)(smem + 131072);
  if (threadIdx.x < 4) stw[threadIdx.x] = 0u;
  __syncthreads();
  XcdBarrier bar = xcd_barrier_post(reinterpret_cast<unsigned*>(p.ws + O_BAR), stw);
  for (int ph = p.lo; ph < p.hi; ++ph) {
    if (ph >= 2 && ((ph - 2) % 13 == 6 || (ph - 2) % 13 == 4)) continue;
    run_phase(p, ph);
    if (ph + 1 < p.hi) {
      if (p.lo < 0) cg::this_grid().sync();
      xcd_barrier(bar);
    }
  }
}

extern "C" void kernel_launch(void* const* d_in, const int* in_sizes, int n_in, void* d_out, int out_size, void* d_ws, size_t ws_size, hipStream_t stream) {
  static int grid = 0;
  if (grid == 0) {
    if (n_in != 31 || ws_size < O_END) { fprintf(stderr, "kernel_launch: unexpected inputs (n_in %d, ws %zu < %zu)\n", n_in, ws_size, (size_t)O_END); grid = -1; return; }
    if (hipFuncSetAttribute((const void*)fwd_kernel, hipFuncAttributeMaxDynamicSharedMemorySize, LDS_BYTES) != hipSuccess) { fprintf(stderr, "hipFuncSetAttribute failed\n"); grid = -1; return; }
    int dev = 0, cus = 0, per_cu = 0;
    hipGetDevice(&dev);
    hipDeviceGetAttribute(&cus, hipDeviceAttributeMultiprocessorCount, dev);
    hipOccupancyMaxActiveBlocksPerMultiprocessor(&per_cu, (const void*)fwd_kernel, 512, LDS_BYTES);
    if (per_cu < 1) { fprintf(stderr, "occupancy query returned %d\n", per_cu); per_cu = 1; }
    grid = cus * 1;
    (void)hipGetLastError();
  }
  if (grid < 0) return;
  (void)hipMemsetAsync((unsigned char*)d_ws + O_BAR, 0, 16384, stream);
  Params p{};
  for (int i = 0; i < 31; ++i) p.in[i] = (const float*)d_in[i];
  p.out = (float*)d_out; p.ws = (unsigned char*)d_ws;
#if COOP
  p.lo = 0; p.hi = NPHASE;
  void* args[] = {&p};
  hipError_t e = hipLaunchCooperativeKernel((const void*)fwd_kernel, dim3(grid), dim3(512), args, LDS_BYTES, stream);
  if (e != hipSuccess) fprintf(stderr, "cooperative launch failed: %s (grid %d)\n", hipGetErrorString(e), grid);
#else
  for (int ph = 0; ph < NPHASE; ++ph) {
    p.lo = ph; p.hi = ph + 1;
    hipLaunchKernelGGL(fwd_kernel, dim3(grid), dim3(512), LDS_BYTES, stream, p);
  }
#endif
}
```
